# Optimizing an MI355X kernel written in HIP

```python
import math
import jax, jax.numpy as jnp
from jax import lax
import numpy as np

D_MODEL = 1024
BATCH = 32
SEQ = 2048
DEPTH = 2

HEAD_DIM = 64
BLOCK = 128
LRU_WIDTH = D_MODEL // 2
LRU_BLOCKS = 8
LRU_BLOCK = LRU_WIDTH // LRU_BLOCKS
CONV_WIDTH = 4
LRU_C = 8.0
FOX_HEADS = (D_MODEL // 2) // HEAD_DIM
DIL_HEADS = (D_MODEL // 2) // HEAD_DIM
DIL_PATTERN = ((128, 1), (512, 4), (2048, 16))
SWA_Q_HEADS = (D_MODEL // 2) // HEAD_DIM
SWA_KV_HEADS = 2
SWA_WINDOW = 128
MEM_LEN = 256
XA_HEADS = 4
XA_HEAD_DIM = D_MODEL // XA_HEADS
D_FF = 4 * D_MODEL
ROPE_THETA = 10000.0
EPS = 1e-6

N_EVEN = (DEPTH + 1) // 2
N_ODD = DEPTH // 2
FOX_W = FOX_HEADS * HEAD_DIM
DIL_W = DIL_HEADS * HEAD_DIM
SWA_QW = SWA_Q_HEADS * HEAD_DIM
SWA_KW = SWA_KV_HEADS * HEAD_DIM
AB_IN = 2 * LRU_WIDTH + 3 * FOX_W + FOX_HEADS
AB_MIX = LRU_WIDTH + FOX_W
CD_IN = 3 * DIL_W + SWA_QW + 2 * SWA_KW
CD_MIX = DIL_W + SWA_QW

kernel_name = "hybrid_rglru_fox_dilated_swa_trunk"


def rmsnorm(x, g):
    xf = x.astype(jnp.float32)
    y = xf * lax.rsqrt(jnp.mean(xf * xf, axis=-1, keepdims=True) + EPS)
    return (y * g.astype(jnp.float32)).astype(x.dtype)


def rope(x, pos):
    half = x.shape[-1] // 2
    inv = ROPE_THETA ** (-jnp.arange(half, dtype=jnp.float32) / half)
    ang = pos.astype(jnp.float32)[:, None] * inv[None, :]
    cos = jnp.cos(ang)[None, :, None, :]
    sin = jnp.sin(ang)[None, :, None, :]
    xf = x.astype(jnp.float32)
    x1, x2 = xf[..., :half], xf[..., half:]
    return jnp.concatenate([x1 * cos - x2 * sin, x2 * cos + x1 * sin], axis=-1).astype(x.dtype)


def causal_depthwise_conv(u, w, b):
    out = lax.conv_general_dilated(
        u, w[:, None, :].astype(u.dtype), window_strides=(1,),
        padding=[(CONV_WIDTH - 1, 0)], dimension_numbers=("NWC", "WIO", "NWC"),
        feature_group_count=u.shape[-1])
    return out + b.astype(u.dtype)


def _linear_recurrence_combine(e1, e2):
    a1, b1 = e1
    a2, b2 = e2
    return a1 * a2, a2 * b1 + b2


def rg_lru(u, w_a, b_a, w_i, b_i, lam):
    bsz, s, c = u.shape
    uf = u.astype(jnp.float32)
    ub = uf.reshape(bsz, s, LRU_BLOCKS, LRU_BLOCK)
    r = jax.nn.sigmoid(jnp.einsum("bsgc,gcd->bsgd", ub, w_a.astype(jnp.float32)).reshape(bsz, s, c) + b_a.astype(jnp.float32))
    i = jax.nn.sigmoid(jnp.einsum("bsgc,gcd->bsgd", ub, w_i.astype(jnp.float32)).reshape(bsz, s, c) + b_i.astype(jnp.float32))
    log_a = -LRU_C * r * jax.nn.softplus(-lam.astype(jnp.float32))
    a = jnp.exp(log_a)
    x_in = jnp.sqrt(-jnp.expm1(2.0 * log_a)) * (i * uf)
    _, h = lax.associative_scan(_linear_recurrence_combine, (a, x_in), axis=1)
    return h.astype(u.dtype)


def forgetting_attention(q, k, v, log_f):
    s_len = q.shape[1]
    scale = q.shape[-1] ** -0.5
    c = jnp.cumsum(log_f, axis=1).transpose(0, 2, 1)
    outs = []
    for blk in range(s_len // BLOCK):
        q0, q1 = blk * BLOCK, (blk + 1) * BLOCK
        sc = jnp.einsum("bqhd,bkhd->bhqk", q[:, q0:q1], k[:, :q1]).astype(jnp.float32) * scale
        bias = c[:, :, q0:q1, None] - c[:, :, None, :q1]
        mask = jnp.arange(q0, q1)[:, None] >= jnp.arange(q1)[None, :]
        p = jax.nn.softmax(jnp.where(mask, sc + bias, -jnp.inf), axis=-1)
        outs.append(jnp.einsum("bhqk,bkhd->bqhd", p, v[:, :q1].astype(jnp.float32)))
    return jnp.concatenate(outs, axis=1).astype(q.dtype)


def banded_partial(q, k, v, max_dist):
    n, l, hk, g, dh = q.shape
    nb = -(-l // BLOCK)
    lp = nb * BLOCK
    pad = lp - l
    qb = jnp.pad(q, ((0, 0), (0, pad), (0, 0), (0, 0), (0, 0))).reshape(n, nb, BLOCK, hk, g, dh)
    kp = jnp.pad(k, ((0, 0), (BLOCK, pad), (0, 0), (0, 0))).reshape(n, nb + 1, BLOCK, hk, dh)
    vp = jnp.pad(v, ((0, 0), (BLOCK, pad), (0, 0), (0, 0))).reshape(n, nb + 1, BLOCK, hk, dh)
    kb = jnp.concatenate([kp[:, :-1], kp[:, 1:]], axis=2)
    vb = jnp.concatenate([vp[:, :-1], vp[:, 1:]], axis=2)
    sc = jnp.einsum("nbqhgd,nbkhd->nbhgqk", qb, kb).astype(jnp.float32) * dh ** -0.5
    qpos = jnp.arange(BLOCK)[:, None] + BLOCK
    kpos = jnp.arange(2 * BLOCK)[None, :]
    dist = qpos - kpos
    blk = jnp.arange(nb)[:, None, None]
    valid = (dist >= 0) & (dist <= max_dist) & (blk * BLOCK - BLOCK + kpos >= 0)
    sc = jnp.where(valid[None, :, None, None], sc, -jnp.inf)
    m = jnp.max(sc, axis=-1)
    p = jnp.exp(sc - m[..., None])
    den = jnp.sum(p, axis=-1)
    num = jnp.einsum("nbhgqk,nbkhd->nbqhgd", p, vb.astype(jnp.float32)).reshape(n, lp, hk, g, dh)[:, :l]
    m = m.transpose(0, 1, 4, 2, 3).reshape(n, lp, hk, g)[:, :l]
    den = den.transpose(0, 1, 4, 2, 3).reshape(n, lp, hk, g)[:, :l]
    return num, m, den


def dilated_attention(q, k, v):
    bsz, s, h, dh = q.shape
    nums, ms, dens = [], [], []
    for window, dil in DIL_PATTERN:
        l = s // dil

        def to_classes(t):
            return t.reshape(bsz, l, dil, h, dh).transpose(0, 2, 1, 3, 4).reshape(bsz * dil, l, h, dh)

        num, m, den = banded_partial(to_classes(q)[:, :, :, None, :], to_classes(k), to_classes(v), window // dil)
        nums.append(num[:, :, :, 0].reshape(bsz, dil, l, h, dh).transpose(0, 2, 1, 3, 4).reshape(bsz, s, h, dh))
        ms.append(m[..., 0].reshape(bsz, dil, l, h).transpose(0, 2, 1, 3).reshape(bsz, s, h))
        dens.append(den[..., 0].reshape(bsz, dil, l, h).transpose(0, 2, 1, 3).reshape(bsz, s, h))
    m_tot = ms[0]
    for m in ms[1:]:
        m_tot = jnp.maximum(m_tot, m)
    num_tot = sum(nm * jnp.exp(m - m_tot)[..., None] for nm, m in zip(nums, ms))
    den_tot = sum(dn * jnp.exp(m - m_tot) for dn, m in zip(dens, ms))
    return (num_tot / den_tot[..., None]).astype(q.dtype)


def sliding_window_sink_attention(q, k, v, sink):
    bsz, s, hq, dh = q.shape
    hk = k.shape[2]
    g = hq // hk
    num, m, den = banded_partial(q.reshape(bsz, s, hk, g, dh), k, v, SWA_WINDOW - 1)
    sink_g = sink.astype(jnp.float32).reshape(hk, g)
    m2 = jnp.maximum(m, sink_g)
    w = jnp.exp(m - m2)
    out = num * w[..., None] / (den * w + jnp.exp(sink_g - m2))[..., None]
    return out.reshape(bsz, s, hq, dh).astype(q.dtype)


def mixer_rglru_fox(h, w_in, conv_w, conv_b, w_a, b_a, w_i, b_i, lam, b_f, w_out):
    bsz, s, _ = h.shape
    z = h @ w_in
    u, gate, q, k, v, f_logit = jnp.split(
        z, [LRU_WIDTH, 2 * LRU_WIDTH, 2 * LRU_WIDTH + FOX_W, 2 * LRU_WIDTH + 2 * FOX_W, 2 * LRU_WIDTH + 3 * FOX_W], axis=-1)
    y_a = rg_lru(causal_depthwise_conv(u, conv_w, conv_b), w_a, b_a, w_i, b_i, lam) * jax.nn.gelu(gate)
    log_f = jax.nn.log_sigmoid(f_logit.astype(jnp.float32) + b_f.astype(jnp.float32))
    shp = (bsz, s, FOX_HEADS, HEAD_DIM)
    y_b = forgetting_attention(q.reshape(shp), k.reshape(shp), v.reshape(shp), log_f).reshape(bsz, s, FOX_W)
    return jnp.concatenate([y_a, y_b], axis=-1) @ w_out


def mixer_dilated_swa(h, w_in, sink, w_out):
    bsz, s, _ = h.shape
    pos = jnp.arange(s)
    z = h @ w_in
    qc, kc, vc, qd, kd, vd = jnp.split(
        z, [DIL_W, 2 * DIL_W, 3 * DIL_W, 3 * DIL_W + SWA_QW, 3 * DIL_W + SWA_QW + SWA_KW], axis=-1)
    dshp = (bsz, s, DIL_HEADS, HEAD_DIM)
    y_c = dilated_attention(rope(qc.reshape(dshp), pos), rope(kc.reshape(dshp), pos), vc.reshape(dshp))
    kshp = (bsz, s, SWA_KV_HEADS, HEAD_DIM)
    y_d = sliding_window_sink_attention(rope(qd.reshape(bsz, s, SWA_Q_HEADS, HEAD_DIM), pos),
                                        rope(kd.reshape(kshp), pos), vd.reshape(kshp), sink)
    return jnp.concatenate([y_c.reshape(bsz, s, DIL_W), y_d.reshape(bsz, s, SWA_QW)], axis=-1) @ w_out


def memory_cross_attention(h, mem, g_mem, w_q, w_kv, w_o):
    bsz, s, _ = h.shape
    mem_n = rmsnorm(mem, g_mem)
    q = (h @ w_q).reshape(bsz, s, XA_HEADS, XA_HEAD_DIM)
    k, v = jnp.split(mem_n @ w_kv, 2, axis=-1)
    k = k.reshape(bsz, -1, XA_HEADS, XA_HEAD_DIM)
    v = v.reshape(bsz, -1, XA_HEADS, XA_HEAD_DIM)
    sc = jnp.einsum("bqhd,bkhd->bhqk", q, k).astype(jnp.float32) * XA_HEAD_DIM ** -0.5
    p = jax.nn.softmax(sc, axis=-1)
    o = jnp.einsum("bhqk,bkhd->bqhd", p, v.astype(jnp.float32)).astype(h.dtype)
    return o.reshape(bsz, s, D_MODEL) @ w_o


def squared_relu_mlp(h, w_up, w_down):
    return jnp.square(jax.nn.relu(h @ w_up)) @ w_down


def setup_inputs(seed: int = 0) -> dict:
    key = jax.random.key(seed)
    ks = iter(jax.random.split(key, 40))
    f32 = jnp.float32

    def nrm(shape, scale):
        return scale * jax.random.normal(next(ks), shape, f32)

    def gain(shape):
        return 1.0 + 0.05 * jax.random.normal(next(ks), shape, f32)

    a8 = jax.random.uniform(next(ks), (N_EVEN, LRU_WIDTH), f32, 0.9, 0.999)
    a0 = a8 ** (1.0 / LRU_C)
    lru_lambda = jnp.log(a0) - jnp.log1p(-a0)
    return {
        "x": nrm((BATCH, SEQ, D_MODEL), 1.0),
        "mem": nrm((BATCH, MEM_LEN, D_MODEL), 1.0),
        "ab_norm": gain((N_EVEN, D_MODEL)),
        "ab_w_in": nrm((N_EVEN, D_MODEL, AB_IN), D_MODEL ** -0.5),
        "ab_conv_w": nrm((N_EVEN, CONV_WIDTH, LRU_WIDTH), CONV_WIDTH ** -0.5),
        "ab_conv_b": nrm((N_EVEN, LRU_WIDTH), 0.05),
        "lru_w_a": nrm((N_EVEN, LRU_BLOCKS, LRU_BLOCK, LRU_BLOCK), LRU_BLOCK ** -0.5),
        "lru_b_a": nrm((N_EVEN, LRU_WIDTH), 0.05),
        "lru_w_i": nrm((N_EVEN, LRU_BLOCKS, LRU_BLOCK, LRU_BLOCK), LRU_BLOCK ** -0.5),
        "lru_b_i": nrm((N_EVEN, LRU_WIDTH), 0.05),
        "lru_lambda": lru_lambda,
        "fox_b_f": jax.random.uniform(next(ks), (N_EVEN, FOX_HEADS), f32, 1.0, 4.0),
        "ab_w_out": nrm((N_EVEN, AB_MIX, D_MODEL), AB_MIX ** -0.5),
        "cd_norm": gain((N_ODD, D_MODEL)),
        "cd_w_in": nrm((N_ODD, D_MODEL, CD_IN), D_MODEL ** -0.5),
        "cd_sink": nrm((N_ODD, SWA_Q_HEADS), 0.5),
        "cd_w_out": nrm((N_ODD, CD_MIX, D_MODEL), CD_MIX ** -0.5),
        "xa_norm": gain((DEPTH, D_MODEL)),
        "xa_mem_norm": gain((DEPTH, D_MODEL)),
        "xa_w_q": nrm((DEPTH, D_MODEL, D_MODEL), D_MODEL ** -0.5),
        "xa_w_kv": nrm((DEPTH, D_MODEL, 2 * D_MODEL), D_MODEL ** -0.5),
        "xa_w_o": nrm((DEPTH, D_MODEL, D_MODEL), D_MODEL ** -0.5),
        "mlp_norm": gain((DEPTH, D_MODEL)),
        "mlp_w_up": nrm((DEPTH, D_MODEL, D_FF), D_MODEL ** -0.5),
        "mlp_w_down": nrm((DEPTH, D_FF, D_MODEL), D_FF ** -0.5),
        "final_norm": gain((D_MODEL,)),
    }


def reference(x, mem, ab_norm, ab_w_in, ab_conv_w, ab_conv_b, lru_w_a, lru_b_a, lru_w_i, lru_b_i,
              lru_lambda, fox_b_f, ab_w_out, cd_norm, cd_w_in, cd_sink, cd_w_out,
              xa_norm, xa_mem_norm, xa_w_q, xa_w_kv, xa_w_o, mlp_norm, mlp_w_up, mlp_w_down, final_norm):
    h = x
    for layer in range(DEPTH):
        j = layer // 2
        if layer % 2 == 0:
            h = h + mixer_rglru_fox(rmsnorm(h, ab_norm[j]), ab_w_in[j], ab_conv_w[j], ab_conv_b[j],
                                    lru_w_a[j], lru_b_a[j], lru_w_i[j], lru_b_i[j], lru_lambda[j],
                                    fox_b_f[j], ab_w_out[j])
        else:
            h = h + mixer_dilated_swa(rmsnorm(h, cd_norm[j]), cd_w_in[j], cd_sink[j], cd_w_out[j])
        h = h + memory_cross_attention(rmsnorm(h, xa_norm[layer]), mem, xa_mem_norm[layer],
                                       xa_w_q[layer], xa_w_kv[layer], xa_w_o[layer])
        h = h + squared_relu_mlp(rmsnorm(h, mlp_norm[layer]), mlp_w_up[layer], mlp_w_down[layer])
    return rmsnorm(h, final_norm)
```

```cpp
#include <hip/hip_runtime.h>
#include <hip/hip_cooperative_groups.h>
#include <cstdio>
#include <cstdint>
namespace cg = cooperative_groups;
#ifndef PROBE_DRY
#define PROBE_DRY 0
#endif
#ifndef PROBE_DUP
#define PROBE_DUP 0
#endif

#define LAS __attribute__((address_space(3)))
typedef unsigned short bf16_t;
typedef short bf16x8 __attribute__((ext_vector_type(8)));
typedef short s16x4 __attribute__((ext_vector_type(4)));
typedef float f32x4 __attribute__((ext_vector_type(4)));
typedef float f32x2 __attribute__((ext_vector_type(2)));
typedef unsigned u32x4 __attribute__((ext_vector_type(4)));
typedef unsigned u32x2 __attribute__((ext_vector_type(2)));

constexpr int DM = 1024, NB = 32, SEQ = 2048, MTOK = NB * SEQ, MEMLEN = 256, MMEM = NB * MEMLEN;
constexpr int ABN = 2560, AB_IN = 2568, CDN = 2304, DFF = 4096;
constexpr float EPS = 1e-6f;
constexpr float LOG2E = 1.4426950408889634f;

typedef __bf16 bf16x2_t __attribute__((ext_vector_type(2)));
__device__ __forceinline__ unsigned pk2(float lo, float hi) { f32x2 v = {lo, hi}; bf16x2_t b = __builtin_convertvector(v, bf16x2_t); return __builtin_bit_cast(unsigned, b); }
__device__ __forceinline__ unsigned f2bf(float f) { return pk2(f, 0.f) & 0xffffu; }
__device__ __forceinline__ float bf2f(unsigned b) { return __uint_as_float(b << 16); }
__device__ __forceinline__ float wave_sum(float v) {
#pragma unroll
    for (int o = 32; o >= 1; o >>= 1) v += __shfl_xor(v, o);
    return v;
}
__device__ __forceinline__ float ex2(float x) { return __builtin_amdgcn_exp2f(x); }
__device__ __forceinline__ float max2f(float x, float y) { return __builtin_amdgcn_fmed3f(x, y, INFINITY); }
__device__ __forceinline__ float max3f(float x, float y, float z) { return max2f(max2f(x, y), z); }
__device__ __forceinline__ float xor16_max(float x) { const auto rr = __builtin_amdgcn_permlane16_swap(__float_as_uint(x), __float_as_uint(x), false, false); return max2f(__uint_as_float(rr[0]), __uint_as_float(rr[1])); }
__device__ __forceinline__ float xor32_max(float x) { const auto rr = __builtin_amdgcn_permlane32_swap(__float_as_uint(x), __float_as_uint(x), false, false); return max2f(__uint_as_float(rr[0]), __uint_as_float(rr[1])); }
__device__ __forceinline__ float xor16_sum(float x) { const auto rr = __builtin_amdgcn_permlane16_swap(__float_as_uint(x), __float_as_uint(x), false, false); return __uint_as_float(rr[0]) + __uint_as_float(rr[1]); }
__device__ __forceinline__ float xor32_sum(float x) { const auto rr = __builtin_amdgcn_permlane32_swap(__float_as_uint(x), __float_as_uint(x), false, false); return __uint_as_float(rr[0]) + __uint_as_float(rr[1]); }
__device__ __forceinline__ float quad_max(float x) { return xor32_max(xor16_max(x)); }
__device__ __forceinline__ float quad_sum(float x) { return xor32_sum(xor16_sum(x)); }
namespace pg8 {
#define PG8_LAS __attribute__((address_space(3)))
typedef unsigned short bf16_t;
typedef short bf16x8 __attribute__((ext_vector_type(8)));
typedef float f32x4 __attribute__((ext_vector_type(4)));
typedef unsigned u32x4 __attribute__((ext_vector_type(4)));
constexpr int BM = 256, BK = 64, HALF = 128, HTB = HALF * BK * 2  , STAGE_BYTES = 8 * HTB, NXCD = 8, WGM = 8;

__host__ __device__ __forceinline__ int lds_byte(int r, int c) { const int st = (r >> 4) * 2 + (c >> 5), rr = r & 15, cc = c & 31, ob = rr * 64 + cc * 2; return st * 1024 + (ob ^ (((ob >> 9) & 1) << 5)); }
__host__ __device__ __forceinline__ void stage_rc(int b, int& R, int& C) { const int st = b / 1024, sb = b % 1024, swz = sb ^ (((sb >> 9) & 1) << 5); R = (st >> 1) * 16 + swz / 64; C = (st & 1) * 32 + (swz % 64) / 2; }
__host__ __device__ __forceinline__ int perm32(int rho) { const int n = rho >> 4, i = rho & 15; return 8 * (i >> 2) + 4 * n + (i & 3); }

struct Unit { int pm, pn; };
struct Gemm { const bf16_t* A; const bf16_t* Bt; int M, N, K; };

struct StaticOrder {
    int nM, nN, nwg, G, c;
    __host__ __device__ void init(int M, int N, int G_, int c_) { nM = M / BM; nN = N / BM; nwg = nM * nN; G = G_; c = c_; }
    __host__ __device__ bool next(int i, Unit& u) const {
        const long L = (long)i * G + c; if (L >= nwg) return false;
        int wgid = (int)L; { const int q = nwg / NXCD, r = nwg % NXCD, xcd = wgid % NXCD, off = wgid / NXCD; wgid = (xcd < r ? xcd * (q + 1) : r * (q + 1) + (xcd - r) * q) + off; }
        const int nig = WGM * nN, gid = wgid / nig, fm = gid * WGM, gsz = (nM - fm) < WGM ? (nM - fm) : WGM;
        u.pm = fm + ((wgid % nig) % gsz); u.pn = (wgid % nig) / gsz; return true;
    }
    __device__ __forceinline__ void a_ready(const Unit&) const {}
    __device__ __forceinline__ void done(const Unit&) const {}
};


__device__ __forceinline__ float row_rstd(const float* ssq, int row) {
    const f32x4* s = (const f32x4*)(ssq + (size_t)row * 16);
    const f32x4 a = s[0], b = s[1], c = s[2], d = s[3];
    const float t = ((a[0] + a[1]) + (a[2] + a[3])) + ((b[0] + b[1]) + (b[2] + b[3])) + ((c[0] + c[1]) + (c[2] + c[3])) + ((d[0] + d[1]) + (d[2] + d[3]));
    return 1.0f / sqrtf(t * (1.0f / 1024.0f) + EPS);
}
__device__ __forceinline__ void rstd8(const float* ssq, int row0, int fq, float (&rs)[8]) {
    f32x4 q[8];
#pragma unroll
    for (int i = 0; i < 8; ++i) q[i] = *(const f32x4*)(ssq + (size_t)(row0 + (i >> 2) * HALF + (i & 3) * 16) * 16 + 4 * fq);
    __builtin_amdgcn_sched_barrier(0);
#pragma unroll
    for (int i = 0; i < 8; ++i) { const float t = quad_sum((q[i][0] + q[i][1]) + (q[i][2] + q[i][3])); rs[i] = __builtin_amdgcn_rsqf(t * (1.0f / 1024.0f) + EPS); }
}
template <int ACT> struct EpiScale {
    static constexpr bool PERM = true, AFTER_DRAIN = false;
    bf16_t* O; int ldc; const float* ssq;
    __device__ __forceinline__ void operator()(const f32x4 (&acc)[2][2][4][2], const Unit& u, int wr, int wc, int fr, int fq) const {
        const int row0 = u.pm * BM + wr * 64 + fr, col0 = u.pn * BM + wc * 32 + 8 * fq;
        float rs[8];
        if (ssq) rstd8(ssq, row0, fq, rs);
        else {
#pragma unroll
            for (int i = 0; i < 8; ++i) rs[i] = 1.0f;
        }
#pragma unroll
        for (int ai = 0; ai < 2; ++ai)
#pragma unroll
            for (int m = 0; m < 4; ++m) {
                const int row = row0 + ai * HALF + m * 16;
                const float r1 = rs[ai * 4 + m];
                bf16_t* rowp = O + (size_t)row * ldc + col0;
#pragma unroll
                for (int bj = 0; bj < 2; ++bj) {
                    f32x4 v0 = acc[ai][bj][m][0] * r1, v1 = acc[ai][bj][m][1] * r1;
                    if (ACT == 1) {
#pragma unroll
                        for (int e = 0; e < 4; ++e) { float a = fmaxf(v0[e], 0.f), b = fmaxf(v1[e], 0.f); v0[e] = a * a; v1[e] = b * b; }
                    }
                    u32x4 w; w.x = pk2(v0[0], v0[1]); w.y = pk2(v0[2], v0[3]); w.z = pk2(v1[0], v1[1]); w.w = pk2(v1[2], v1[3]);
                    *(u32x4*)(rowp + bj * HALF) = w;
                }
            }
    }
};
struct EpiResid {
    static constexpr bool PERM = true, AFTER_DRAIN = false;
    bf16_t* hb; float* ssq;
    __device__ __forceinline__ void operator()(const f32x4 (&acc)[2][2][4][2], const Unit& u, int wr, int wc, int fr, int fq) const {
        const int row0 = u.pm * BM + wr * 64 + fr, col0 = u.pn * BM + wc * 32 + 8 * fq;
        u32x4 bw[8][2];
#pragma unroll
        for (int i = 0; i < 8; ++i)
#pragma unroll
            for (int bj = 0; bj < 2; ++bj) bw[i][bj] = *(const u32x4*)(hb + (size_t)(row0 + (i >> 2) * HALF + (i & 3) * 16) * DM + col0 + bj * HALF);
        __builtin_amdgcn_sched_barrier(0);
#pragma unroll
        for (int ai = 0; ai < 2; ++ai)
#pragma unroll
            for (int m = 0; m < 4; ++m) {
                const int row = row0 + ai * HALF + m * 16;
                const size_t off = (size_t)row * DM + col0;
                float sq = 0.f;
#pragma unroll
                for (int bj = 0; bj < 2; ++bj) {
                    const u32x4 b4 = bw[ai * 4 + m][bj];
                    f32x4 v0 = acc[ai][bj][m][0], v1 = acc[ai][bj][m][1];
                    v0[0] += __uint_as_float(b4.x << 16); v0[1] += __uint_as_float(b4.x & 0xffff0000u); v0[2] += __uint_as_float(b4.y << 16); v0[3] += __uint_as_float(b4.y & 0xffff0000u);
                    v1[0] += __uint_as_float(b4.z << 16); v1[1] += __uint_as_float(b4.z & 0xffff0000u); v1[2] += __uint_as_float(b4.w << 16); v1[3] += __uint_as_float(b4.w & 0xffff0000u);
                    u32x4 w; w.x = pk2(v0[0], v0[1]); w.y = pk2(v0[2], v0[3]); w.z = pk2(v1[0], v1[1]); w.w = pk2(v1[2], v1[3]);
                    *(u32x4*)(hb + off + bj * HALF) = w;
                    sq += (v0[0] * v0[0] + v0[1] * v0[1]) + (v0[2] * v0[2] + v0[3] * v0[3]) + (v1[0] * v1[0] + v1[1] * v1[1]) + (v1[2] * v1[2] + v1[3] * v1[3]);
                }
                sq = quad_sum(sq);
                if (fq == 0) ssq[(size_t)row * 16 + u.pn * 4 + wc] = sq;
            }
    }
};
struct EpiRope {
    static constexpr bool PERM = false, AFTER_DRAIN = false;
    bf16_t* O; const float* ssq; const f32x2* tab;
    __device__ __forceinline__ void operator()(const f32x4 (&acc)[2][2][4][2], const Unit& u, int wr, int wc, int fr, int fq) const {
        const int row0 = u.pm * BM + wr * 64 + fr;
        const int hh = wc & 1;
        float rs[8];
        rstd8(ssq, row0, fq, rs);
#pragma unroll
        for (int ai = 0; ai < 2; ++ai) {
            f32x4 tb[4][2];
#pragma unroll
            for (int i = 0; i < 4; ++i) {
                const int pos = (row0 + ai * HALF + i * 16) & (SEQ - 1);
                const f32x4* t4 = (const f32x4*)(tab + (size_t)pos * 32 + 16 * hh + 4 * fq);
                tb[i][0] = t4[0]; tb[i][1] = t4[1];
            }
            __builtin_amdgcn_sched_barrier(0);
#pragma unroll
            for (int m = 0; m < 4; ++m) {
                const int row = row0 + ai * HALF + m * 16;
                const float r1 = rs[ai * 4 + m];
                const size_t hrow = (size_t)(row >> 11) * 36 * SEQ + (row & (SEQ - 1));
#pragma unroll
                for (int bj = 0; bj < 2; ++bj) {
                    const int gcol = u.pn * BM + bj * HALF + wc * 32;
                    const bool rope = (gcol < 1024) || (gcol >= 1536 && gcol < 2176);
                    f32x4 a = acc[ai][bj][m][0] * r1, b = acc[ai][bj][m][1] * r1;
                    int ca, cb;
                    if (rope) {
                        const f32x4 t0 = tb[m][0], t1 = tb[m][1];
                        f32x4 x1, x2;
                        x1[0] = a[0] * t0[0] - b[0] * t0[1]; x2[0] = b[0] * t0[0] + a[0] * t0[1];
                        x1[1] = a[1] * t0[2] - b[1] * t0[3]; x2[1] = b[1] * t0[2] + a[1] * t0[3];
                        x1[2] = a[2] * t1[0] - b[2] * t1[1]; x2[2] = b[2] * t1[0] + a[2] * t1[1];
                        x1[3] = a[3] * t1[2] - b[3] * t1[3]; x2[3] = b[3] * t1[2] + a[3] * t1[3];
                        a = x1; b = x2;
                        ca = (gcol & ~63) + 16 * hh + 4 * fq; cb = ca + 32;
                    } else { ca = gcol + 4 * fq; cb = ca + 16; }
                    u32x2 wa, wb; wa.x = pk2(a[0], a[1]); wa.y = pk2(a[2], a[3]); wb.x = pk2(b[0], b[1]); wb.y = pk2(b[2], b[3]);
                    bf16_t* hp = O + (hrow + (size_t)(ca >> 6) * SEQ) * 64;
                    *(u32x2*)(hp + (ca & 63)) = wa; *(u32x2*)(hp + (cb & 63)) = wb;
                }
            }
        }
    }
};

template <class Epi, class Sched, bool ALIGN_EPI = false, bool SP2 = false>
__device__ __forceinline__ void gemm_phase(PG8_LAS unsigned char* lds, const Gemm g, const Sched& S, const Epi& E) {
    int tid_l = threadIdx.x; asm volatile("" : "+v"(tid_l)); const int tid = tid_l, wid = __builtin_amdgcn_readfirstlane(tid >> 6), lane = tid & 63, wr = wid >> 2, wc = wid & 3, fr = lane & 15, fq = lane >> 4;
    const int K = g.K, nt = K / BK;
    unsigned voffA[2], voffB[2];
#pragma unroll
    for (int i = 0; i < 2; ++i) { int R, C; stage_rc(tid * 16 + i * 8192, R, C); const int Rb = Epi::PERM ? ((R & ~31) + perm32(R & 31)) : R;
        voffA[i] = (unsigned)(R * K + C) * 2u; voffB[i] = (unsigned)(Rb * K + C) * 2u; }
    const size_t kstep = (size_t)(BK * 2);
    const size_t hstep = (size_t)HALF * K * 2;
    const size_t tstep = 2 * hstep;
    const unsigned ldsw = (unsigned)wid * 1024u;
    const int aoff = lds_byte(wr * 64 + fr, fq * 8), boff = lds_byte(wc * 32 + fr, fq * 8);
#define PG8_SA(b, h) (((b) * 2 + (h)) * HTB)
#define PG8_SB(b, h) ((4 + (b) * 2 + (h)) * HTB)
#define PG8_STAGE(bufoff, gbase, voff) do { _Pragma("unroll") for (int _i = 0; _i < 2; ++_i) \
        __builtin_amdgcn_global_load_lds((const unsigned*)((const char*)(gbase) + (voff)[_i]), (PG8_LAS unsigned*)(lds + (bufoff) + ldsw + _i * 8192), 16, 0, 0); } while (0)
#define PG8_LDA(dst, b, h) do { _Pragma("unroll") for (int m = 0; m < 4; ++m) _Pragma("unroll") for (int k = 0; k < 2; ++k) dst[m][k] = *(const PG8_LAS bf16x8*)(lds + PG8_SA(b, h) + aoff + m * 2048 + k * 1024); } while (0)
#define PG8_LDB(dst, b, h) do { _Pragma("unroll") for (int n = 0; n < 2; ++n) _Pragma("unroll") for (int k = 0; k < 2; ++k) dst[n][k] = *(const PG8_LAS bf16x8*)(lds + PG8_SB(b, h) + boff + n * 2048 + k * 1024); } while (0)
#define PG8_MMA(ai, bj, At, Bt) do { __builtin_amdgcn_s_setprio(1); _Pragma("unroll") for (int m = 0; m < 4; ++m) _Pragma("unroll") for (int n = 0; n < 2; ++n) _Pragma("unroll") for (int k = 0; k < 2; ++k) \
        acc[ai][bj][m][n] = __builtin_amdgcn_mfma_f32_16x16x32_bf16(Bt[n][k], At[m][k], acc[ai][bj][m][n], 0, 0, 0); __builtin_amdgcn_s_setprio(0); } while (0)
#define PG8_WAIT_V(n) asm volatile("s_waitcnt vmcnt(" #n ")" ::: "memory")
#define PG8_WAIT_L(n) asm volatile("s_waitcnt lgkmcnt(" #n ")" ::: "memory")
#define PG8_BAR __builtin_amdgcn_s_barrier()
#define PG8_SCHED __builtin_amdgcn_sched_barrier(0)
    Unit cur, nxt; int ui = 0;
    if (!S.next(0, cur)) return;
    f32x4 acc[2][2][4][2];
#pragma unroll
    for (int a = 0; a < 2; ++a)
#pragma unroll
        for (int b = 0; b < 2; ++b)
#pragma unroll
            for (int m = 0; m < 4; ++m)
#pragma unroll
                for (int n = 0; n < 2; ++n) acc[a][b][m][n] = (f32x4){0.f, 0.f, 0.f, 0.f};
    bf16x8 At[4][2], B0[2][2], B1[2][2];
    const char* cA = (const char*)g.A + (size_t)cur.pm * tstep; const char* cB = (const char*)g.Bt + (size_t)cur.pn * tstep;
    S.a_ready(cur);
    if constexpr (SP2) {
        PG8_STAGE(PG8_SB(0, 0), cB, voffB); PG8_STAGE(PG8_SB(0, 1), cB + hstep, voffB); PG8_STAGE(PG8_SA(0, 0), cA, voffA); PG8_STAGE(PG8_SA(0, 1), cA + hstep, voffA);
        if (wr == 1) PG8_BAR;
        PG8_WAIT_V(2); PG8_BAR;
        PG8_STAGE(PG8_SB(1, 0), cB + kstep, voffB); PG8_STAGE(PG8_SA(1, 0), cA + kstep, voffA); PG8_STAGE(PG8_SB(1, 1), cB + hstep + kstep, voffB);
        PG8_WAIT_V(6); PG8_BAR;
    } else {
        PG8_STAGE(PG8_SB(0, 0), cB, voffB); PG8_STAGE(PG8_SA(0, 0), cA, voffA); PG8_STAGE(PG8_SB(0, 1), cB + hstep, voffB); PG8_STAGE(PG8_SA(0, 1), cA + hstep, voffA);
        if (wr == 1) PG8_BAR;
        PG8_WAIT_V(4); PG8_BAR;
        PG8_STAGE(PG8_SB(1, 0), cB + kstep, voffB); PG8_STAGE(PG8_SA(1, 0), cA + kstep, voffA); PG8_STAGE(PG8_SB(1, 1), cB + hstep + kstep, voffB);
        PG8_WAIT_V(6); PG8_BAR;
    }
    for (;;) {
        const bool has_next = S.next(ui + 1, nxt);
        const char* nA = has_next ? (const char*)g.A + (size_t)nxt.pm * tstep : cA; const char* nB = has_next ? (const char*)g.Bt + (size_t)nxt.pn * tstep : cB;
        for (int t = 0; t < nt; t += 2) {
            const bool last = (t == nt - 2);
            const char* a1 = cA + (size_t)(t + 1) * kstep;
            const char* a2 = last ? nA : cA + (size_t)(t + 2) * kstep; const char* b2 = last ? nB : cB + (size_t)(t + 2) * kstep;
            const char* a3 = a2 + kstep; const char* b3 = b2 + kstep;
            if (last && has_next) S.a_ready(nxt);
            if constexpr (SP2) {
            PG8_LDB(B0, 0, 0); PG8_LDB(B1, 0, 1); PG8_SCHED; PG8_LDA(At, 0, 0); PG8_STAGE(PG8_SA(1, 1), a1 + hstep, voffA);
            PG8_WAIT_V(8); PG8_WAIT_L(0); PG8_BAR; PG8_MMA(0, 0, At, B0); PG8_MMA(0, 1, At, B1); PG8_BAR; PG8_SCHED;
            PG8_LDA(At, 0, 1); PG8_STAGE(PG8_SB(0, 0), b2, voffB); PG8_STAGE(PG8_SB(0, 1), b2 + hstep, voffB); PG8_STAGE(PG8_SA(0, 0), a2, voffA);
            PG8_WAIT_V(8); PG8_WAIT_L(0); PG8_BAR; PG8_MMA(1, 0, At, B0); PG8_MMA(1, 1, At, B1); PG8_BAR; PG8_SCHED;
            PG8_LDB(B0, 1, 0); PG8_LDB(B1, 1, 1); PG8_SCHED; PG8_LDA(At, 1, 0); PG8_STAGE(PG8_SA(0, 1), a2 + hstep, voffA);
            PG8_WAIT_V(8); PG8_WAIT_L(0); PG8_BAR; PG8_MMA(0, 0, At, B0); PG8_MMA(0, 1, At, B1); PG8_BAR; PG8_SCHED;
            PG8_LDA(At, 1, 1); PG8_STAGE(PG8_SB(1, 0), b3, voffB); PG8_STAGE(PG8_SB(1, 1), b3 + hstep, voffB); PG8_STAGE(PG8_SA(1, 0), a3, voffA);
            PG8_WAIT_V(8); PG8_WAIT_L(0); PG8_BAR; PG8_MMA(1, 0, At, B0); PG8_MMA(1, 1, At, B1); PG8_BAR; PG8_SCHED;
            } else {
            PG8_LDB(B0, 0, 0); PG8_SCHED; PG8_LDA(At, 0, 0); PG8_STAGE(PG8_SA(1, 1), a1 + hstep, voffA);
            PG8_WAIT_L(8); PG8_BAR; PG8_WAIT_L(0); PG8_MMA(0, 0, At, B0); PG8_BAR; PG8_SCHED;
            PG8_LDB(B1, 0, 1); PG8_STAGE(PG8_SB(0, 0), b2, voffB);
            PG8_BAR; PG8_WAIT_L(0); PG8_MMA(0, 1, At, B1); PG8_BAR;
            PG8_LDA(At, 0, 1); PG8_STAGE(PG8_SA(0, 0), a2, voffA);
            PG8_BAR; PG8_WAIT_L(0); PG8_MMA(1, 0, At, B0); PG8_BAR; PG8_SCHED;
            PG8_STAGE(PG8_SB(0, 1), b2 + hstep, voffB);
            PG8_WAIT_V(6); PG8_BAR; PG8_MMA(1, 1, At, B1); PG8_BAR;
            PG8_LDB(B0, 1, 0); PG8_SCHED; PG8_LDA(At, 1, 0); PG8_STAGE(PG8_SA(0, 1), a2 + hstep, voffA);
            PG8_WAIT_L(8); PG8_BAR; PG8_WAIT_L(0); PG8_MMA(0, 0, At, B0); PG8_BAR; PG8_SCHED;
            PG8_LDB(B1, 1, 1); PG8_STAGE(PG8_SB(1, 0), b3, voffB);
            PG8_BAR; PG8_WAIT_L(0); PG8_MMA(0, 1, At, B1); PG8_BAR;
            PG8_LDA(At, 1, 1); PG8_STAGE(PG8_SA(1, 0), a3, voffA);
            PG8_BAR; PG8_WAIT_L(0); PG8_MMA(1, 0, At, B0); PG8_BAR; PG8_SCHED;
            PG8_STAGE(PG8_SB(1, 1), b3 + hstep, voffB);
            PG8_WAIT_V(6); PG8_BAR; PG8_MMA(1, 1, At, B1); PG8_BAR;
            }
        }
        if constexpr (ALIGN_EPI) { if (wr == 0) PG8_BAR; }
        if constexpr (!Epi::AFTER_DRAIN) { E(acc, cur, wr, wc, fr, fq); S.done(cur); }
        if (!has_next) break;
#pragma unroll
        for (int a = 0; a < 2; ++a)
#pragma unroll
            for (int b = 0; b < 2; ++b)
#pragma unroll
                for (int m = 0; m < 4; ++m)
#pragma unroll
                    for (int n = 0; n < 2; ++n) acc[a][b][m][n] = (f32x4){0.f, 0.f, 0.f, 0.f};
        cur = nxt; cA = nA; cB = nB; ++ui;
        if constexpr (ALIGN_EPI) { if (wr == 1) PG8_BAR; }
    }
    PG8_WAIT_V(0);
    if constexpr (!ALIGN_EPI) { if (wr == 0) PG8_BAR; }
    PG8_BAR;
    if constexpr (Epi::AFTER_DRAIN) { E.fused(acc, cur, wr, wc, fr, fq, lds, wid, lane); S.done(cur); }
#undef PG8_SA
#undef PG8_SB
#undef PG8_STAGE
#undef PG8_LDA
#undef PG8_LDB
#undef PG8_MMA
#undef PG8_WAIT_V
#undef PG8_WAIT_L
#undef PG8_BAR
#undef PG8_SCHED
}
}

constexpr size_t MiB = 1024 * 1024;
constexpr size_t WS_WIN0 = 0;
constexpr size_t WS_WOUT0 = WS_WIN0 + (size_t)ABN * DM * 2;
constexpr size_t WS_WIN1 = WS_WOUT0 + 2 * MiB;
constexpr size_t WS_WOUT1 = WS_WIN1 + (size_t)CDN * DM * 2;
constexpr size_t WS_WQ = WS_WOUT1 + 2 * MiB;
constexpr size_t WS_WKV = WS_WQ + 4 * MiB;
constexpr size_t WS_WO = WS_WKV + 8 * MiB;
constexpr size_t WS_WUP = WS_WO + 4 * MiB;
constexpr size_t WS_WDN = WS_WUP + 16 * MiB;
constexpr size_t WS_HB = WS_WDN + 16 * MiB;
constexpr size_t WS_SSQ = WS_HB + 128 * MiB;
constexpr size_t WS_R1 = WS_SSQ + 4 * MiB;
constexpr size_t WS_Y = WS_R1 + 512 * MiB;
constexpr size_t WS_KV = WS_Y + 128 * MiB;
constexpr size_t WS_MEMN = WS_KV + 64 * MiB;
constexpr size_t WS_CS = WS_MEMN + 32 * MiB;
constexpr size_t WS_FL = WS_CS + 2 * MiB;
constexpr size_t WS_ROPE = WS_FL + 2 * MiB;
constexpr size_t WS_BAR = WS_ROPE + MiB / 2;
constexpr size_t WS_BAR_BYTES = 32768;
constexpr size_t WS_END = WS_BAR + WS_BAR_BYTES;
static_assert(WS_END <= 1024 * MiB, "workspace");
static_assert(WS_WOUT1 % 256 == 0 && WS_HB % 256 == 0, "align");

constexpr int LDS_BYTES = 155648;

struct Params { const float* in[26]; float* out; unsigned char* ws; };
__device__ __forceinline__ unsigned hw_xcc_id() { return (unsigned)__builtin_amdgcn_s_getreg((3 << 11) | 20) & 0xFu; }

__device__ __forceinline__ int colmap1(int n) {
    const bool rope = (n < 1024) || (n >= 1536 && n < 2176);
    if (!rope) return n;
    const int p = n & 63, hh = p >> 5, pp = p & 31;
    const int orig = (pp < 16) ? (16 * hh + pp) : (32 + 16 * hh + pp - 16);
    return (n & ~63) + orig;
}
__device__ __forceinline__ void conv_weight(LAS float* tile, const float* __restrict__ src, bf16_t* __restrict__ dst, const float* __restrict__ gain, int K, int N, int ldsrc, int mode,
                                            float qs, int qlo, int qhi, int q2lo, int q2hi, int& base) {
    const int G = gridDim.x, tid = threadIdx.x;
    const int nkt = K >> 6, ntiles = nkt * (N >> 6);
    int start = ((int)blockIdx.x - base) % G; if (start < 0) start += G;
    for (int t = start; t < ntiles; t += G) {
        const int k0 = (t % nkt) << 6, n0 = (t / nkt) << 6;
        {
            const int c = tid & 63, r0 = tid >> 6, n = n0 + c;
            const int sc = mode ? colmap1(n) : n;
            const float cs = ((n >= qlo && n < qhi) || (n >= q2lo && n < q2hi)) ? qs : 1.0f;
#pragma unroll
            for (int i = 0; i < 8; ++i) {
                const int r = r0 + 8 * i, k = k0 + r;
                float v = src[(size_t)k * ldsrc + sc] * cs;
                if (gain) v *= gain[k];
                tile[r * 65 + c] = v;
            }
        }
        __syncthreads();
        {
            const int rr = tid >> 3, ch = tid & 7;
            float v[8];
#pragma unroll
            for (int j = 0; j < 8; ++j) v[j] = tile[(ch * 8 + j) * 65 + rr];
            u32x4 w; w.x = pk2(v[0], v[1]); w.y = pk2(v[2], v[3]); w.z = pk2(v[4], v[5]); w.w = pk2(v[6], v[7]);
            *(u32x4*)(dst + (size_t)(n0 + rr) * K + k0 + ch * 8) = w;
        }
        __syncthreads();
    }
    base = (base + ntiles) % G;
}

__device__ __forceinline__ void p0_prologue(const Params& p, LAS unsigned char* lds) {
    unsigned char* ws = p.ws;
    int tid_l = threadIdx.x; asm volatile("" : "+v"(tid_l)); const int tid = tid_l, lane = tid & 63, wid = tid >> 6, G = gridDim.x;
    LAS float* tile = (LAS float*)lds;
    int base = 0;
    const float QS64 = 0.125f * LOG2E, QS256 = 0.0625f * LOG2E;
    conv_weight(tile, p.in[3], (bf16_t*)(ws + WS_WIN0), p.in[2], DM, ABN, AB_IN, 0, QS64, 1024, 1536, 0, 0, base);
    conv_weight(tile, p.in[12], (bf16_t*)(ws + WS_WOUT0), nullptr, DM, DM, DM, 0, 1.f, 0, 0, 0, 0, base);
    conv_weight(tile, p.in[14], (bf16_t*)(ws + WS_WIN1), p.in[13], DM, CDN, CDN, 1, QS64, 0, 512, 1536, 2048, base);
    conv_weight(tile, p.in[16], (bf16_t*)(ws + WS_WOUT1), nullptr, DM, DM, DM, 0, 1.f, 0, 0, 0, 0, base);
    for (int l = 0; l < 2; ++l) {
        conv_weight(tile, p.in[19] + (size_t)l * DM * DM, (bf16_t*)(ws + WS_WQ + l * 2 * MiB), p.in[17] + l * DM, DM, DM, DM, 0, QS256, 0, DM, 0, 0, base);
        conv_weight(tile, p.in[20] + (size_t)l * DM * 2 * DM, (bf16_t*)(ws + WS_WKV + l * 4 * MiB), nullptr, DM, 2 * DM, 2 * DM, 0, 1.f, 0, 0, 0, 0, base);
        conv_weight(tile, p.in[21] + (size_t)l * DM * DM, (bf16_t*)(ws + WS_WO + l * 2 * MiB), nullptr, DM, DM, DM, 0, 1.f, 0, 0, 0, 0, base);
        conv_weight(tile, p.in[23] + (size_t)l * DM * DFF, (bf16_t*)(ws + WS_WUP + l * 8 * MiB), p.in[22] + l * DM, DM, DFF, DFF, 0, 1.f, 0, 0, 0, 0, base);
        conv_weight(tile, p.in[24] + (size_t)l * DFF * DM, (bf16_t*)(ws + WS_WDN + l * 8 * MiB), nullptr, DFF, DM, DM, 0, 1.f, 0, 0, 0, 0, base);
    }
    __syncthreads();
    LAS float* wf = (LAS float*)lds;
    for (int i = tid; i < 8 * DM; i += 512) { const int j = i >> 10, k = i & 1023; wf[i] = p.in[3][(size_t)k * AB_IN + ABN + j] * p.in[2][k]; }
    __syncthreads();
    const int gw = blockIdx.x * 8 + wid, NGW = G * 8;
    bf16_t* hb = (bf16_t*)(ws + WS_HB);
    float* ssq = (float*)(ws + WS_SSQ);
    float* fl = (float*)(ws + WS_FL);
    f32x4 vn[4];
    if (gw < MTOK) {
        const f32x4* xr0 = (const f32x4*)(p.in[0] + (size_t)gw * DM);
#pragma unroll
        for (int i = 0; i < 4; ++i) vn[i] = __builtin_nontemporal_load(xr0 + lane + 64 * i);
    }
    for (int row = gw; row < MTOK; row += NGW) {
        f32x4 v[4];
#pragma unroll
        for (int i = 0; i < 4; ++i) v[i] = vn[i];
        if (row + NGW < MTOK) {
            const f32x4* xr = (const f32x4*)(p.in[0] + (size_t)(row + NGW) * DM);
#pragma unroll
            for (int i = 0; i < 4; ++i) vn[i] = __builtin_nontemporal_load(xr + lane + 64 * i);
        }
        float s = 0.f, a[8];
#pragma unroll
        for (int j = 0; j < 8; ++j) a[j] = 0.f;
#pragma unroll
        for (int i = 0; i < 4; ++i) {
            s += (v[i][0] * v[i][0] + v[i][1] * v[i][1]) + (v[i][2] * v[i][2] + v[i][3] * v[i][3]);
#pragma unroll
            for (int j = 0; j < 8; ++j) { const f32x4 w = *(const LAS f32x4*)(wf + j * DM + 4 * (lane + 64 * i)); a[j] += (v[i][0] * w[0] + v[i][1] * w[1]) + (v[i][2] * w[2] + v[i][3] * w[3]); }
            u32x2 w2; w2.x = pk2(v[i][0], v[i][1]); w2.y = pk2(v[i][2], v[i][3]);
            *(u32x2*)(hb + (size_t)row * DM + 4 * (lane + 64 * i)) = w2;
        }
        s = wave_sum(s);
        const float rs = 1.0f / sqrtf(s * (1.0f / 1024.0f) + EPS);
        float mine = 0.f;
#pragma unroll
        for (int j = 0; j < 8; ++j) { const float t = wave_sum(a[j]) * rs; if (lane == j) mine = t; }
        if (lane < 8) fl[(size_t)row * 8 + lane] = mine;
        if (lane < 16) ssq[(size_t)row * 16 + lane] = (lane == 0) ? s : 0.f;
    }
    for (int row = gw; row < MMEM; row += NGW) {
        const f32x4* xr = (const f32x4*)(p.in[1] + (size_t)row * DM);
        f32x4 v[4];
        float s = 0.f;
#pragma unroll
        for (int i = 0; i < 4; ++i) { v[i] = xr[lane + 64 * i]; s += (v[i][0] * v[i][0] + v[i][1] * v[i][1]) + (v[i][2] * v[i][2] + v[i][3] * v[i][3]); }
        s = wave_sum(s);
        const float rs = 1.0f / sqrtf(s * (1.0f / 1024.0f) + EPS);
#pragma unroll
        for (int l = 0; l < 2; ++l) {
            bf16_t* dst = (bf16_t*)(ws + WS_MEMN + l * 16 * MiB) + (size_t)row * DM;
#pragma unroll
            for (int i = 0; i < 4; ++i) {
                const f32x4 g = *(const f32x4*)(p.in[18] + l * DM + 4 * (lane + 64 * i));
                u32x2 w2; w2.x = pk2(v[i][0] * rs * g[0], v[i][1] * rs * g[1]); w2.y = pk2(v[i][2] * rs * g[2], v[i][3] * rs * g[3]);
                *(u32x2*)(dst + 4 * (lane + 64 * i)) = w2;
            }
        }
    }
    f32x2* tab = (f32x2*)(ws + WS_ROPE);
    for (int idx = blockIdx.x * 512 + tid; idx < SEQ * 32; idx += G * 512) {
        const int pos = idx >> 5, i = idx & 31;
        const float inv = exp2f(-(float)i * (13.287712379549449f / 32.0f));
        const float ang = (float)pos * inv;
        f32x2 cs; cs[0] = cosf(ang); cs[1] = sinf(ang);
        tab[idx] = cs;
    }
    __syncthreads();
}

__device__ __forceinline__ void fox_cumsum(const Params& p) {
    int tid_l = threadIdx.x; asm volatile("" : "+v"(tid_l)); const int tid = tid_l, lane = tid & 63, wid = tid >> 6;
    if (wid != 0) return;
    const float* fl = (const float*)(p.ws + WS_FL);
    float* cs2 = (float*)(p.ws + WS_CS);
    for (int seq = blockIdx.x; seq < NB * 8; seq += gridDim.x) {
        const int b = seq >> 3, h = seq & 7;
        const float bf = p.in[11][h];
        const float* src = fl + ((size_t)b * SEQ + lane * 32) * 8 + h;
        float tot = 0.f;
        for (int i = 0; i < 32; ++i) { const float y = src[i * 8] + bf; tot += fminf(y, 0.f) - log1pf(expf(-fabsf(y))); }
        float incl = tot;
#pragma unroll
        for (int o = 1; o < 64; o <<= 1) { const float t = __shfl_up(incl, o); if (lane >= o) incl += t; }
        float run = incl - tot;
        float* dst = cs2 + (size_t)seq * SEQ + lane * 32;
        for (int i = 0; i < 32; ++i) { const float y = src[i * 8] + bf; run += fminf(y, 0.f) - log1pf(expf(-fabsf(y))); dst[i] = run * LOG2E; }
    }
}

__device__ __forceinline__ s16x4 vtr(LAS const unsigned char* p) { return __builtin_bit_cast(s16x4, __builtin_amdgcn_ds_read_tr16_b64_v4i16((LAS s16x4*)p)); }

template <int NKT, int QT, int DT, int KSTR, int VSTR, class F>
__device__ __forceinline__ void attn_stage(f32x4 (&O)[QT][DT], float (&mrow)[QT], float (&lsum)[QT], const bf16x8 (&Qf)[QT][DT / 2],
                                           LAS const unsigned char* Ks, LAS const unsigned char* Vs, const F& fn, int lane) {
    const int li = lane & 15, g = lane >> 4;
    constexpr int KS = DT / 2;
    constexpr int KTB = (KS >= 8) ? 1 : 2;
    constexpr int NKB = NKT / KTB;
    static_assert(NKT % KTB == 0 && NKT % 2 == 0, "attn_stage shape");
    f32x4 S[QT][NKT];
    if constexpr (KS >= 8) {
        constexpr int HB = KS / 4, NB = NKT * HB;
        bf16x8 kf[2][4];
        LAS const unsigned char* kbase = Ks + li * KSTR + 16 * g;
#pragma unroll
        for (int j = 0; j < 4; ++j) kf[0][j] = *(LAS const bf16x8*)(kbase + 64 * j);
#pragma unroll
        for (int bi = 0; bi < NB; ++bi) {
            if (bi + 1 < NB) {
                const int kt1 = (bi + 1) / HB, k1 = ((bi + 1) % HB) * 4;
#pragma unroll
                for (int j = 0; j < 4; ++j) kf[(bi + 1) & 1][j] = *(LAS const bf16x8*)(kbase + (16 * kt1) * KSTR + 64 * (k1 + j));
            }
            __builtin_amdgcn_sched_barrier(0); __builtin_amdgcn_s_setprio(1);
            const int kt = bi / HB, k0 = (bi % HB) * 4;
            if (k0 == 0) {
                const f32x4 s0 = fn.init(kt);
#pragma unroll
                for (int qt = 0; qt < QT; ++qt) S[qt][kt] = s0;
            }
#pragma unroll
            for (int j = 0; j < 4; ++j)
#pragma unroll
                for (int qt = 0; qt < QT; ++qt) S[qt][kt] = __builtin_amdgcn_mfma_f32_16x16x32_bf16(kf[bi & 1][j], Qf[qt][k0 + j], S[qt][kt], 0, 0, 0);
__builtin_amdgcn_s_setprio(0); __builtin_amdgcn_sched_barrier(0);
        }
    } else {
        bf16x8 kf[2][KTB][KS];
        LAS const unsigned char* kbase = Ks + li * KSTR + 16 * g;
#pragma unroll
        for (int t = 0; t < KTB; ++t)
#pragma unroll
            for (int ks = 0; ks < KS; ++ks) kf[0][t][ks] = *(LAS const bf16x8*)(kbase + (16 * t) * KSTR + 64 * ks);
#pragma unroll
        for (int kb = 0; kb < NKB; ++kb) {
            if (kb + 1 < NKB) {
#pragma unroll
                for (int t = 0; t < KTB; ++t)
#pragma unroll
                    for (int ks = 0; ks < KS; ++ks) kf[(kb + 1) & 1][t][ks] = *(LAS const bf16x8*)(kbase + (16 * ((kb + 1) * KTB + t)) * KSTR + 64 * ks);
            }
            __builtin_amdgcn_sched_barrier(0); __builtin_amdgcn_s_setprio(1);
#pragma unroll
            for (int t = 0; t < KTB; ++t) {
                const int kt = kb * KTB + t;
                const f32x4 s0 = fn.init(kt);
#pragma unroll
                for (int qt = 0; qt < QT; ++qt) S[qt][kt] = s0;
#pragma unroll
                for (int ks = 0; ks < KS; ++ks)
#pragma unroll
                    for (int qt = 0; qt < QT; ++qt) S[qt][kt] = __builtin_amdgcn_mfma_f32_16x16x32_bf16(kf[kb & 1][t][ks], Qf[qt][ks], S[qt][kt], 0, 0, 0);
            }
__builtin_amdgcn_s_setprio(0); __builtin_amdgcn_sched_barrier(0);
        }
    }
#pragma unroll
    for (int qt = 0; qt < QT; ++qt) {
        float mx = -INFINITY;
#pragma unroll
        for (int kt = 0; kt < NKT; ++kt) { S[qt][kt] = fn.apply(S[qt][kt], qt, kt); mx = max3f(mx, S[qt][kt][0], S[qt][kt][1]); mx = max3f(mx, S[qt][kt][2], S[qt][kt][3]); }
        mx = quad_max(mx);
        const float mnew = max2f(mrow[qt], mx);
        const float msub = (mnew == -INFINITY) ? 0.f : mnew;
        const float alpha = ex2(mrow[qt] - msub);
        mrow[qt] = mnew;
        float ps = 0.f;
#pragma unroll
        for (int kt = 0; kt < NKT; ++kt)
#pragma unroll
            for (int e = 0; e < 4; ++e) { const float pv = ex2(S[qt][kt][e] - msub); S[qt][kt][e] = pv; ps += pv; }
        lsum[qt] = lsum[qt] * alpha + ps;
#pragma unroll
        for (int dt = 0; dt < DT; ++dt) O[qt][dt] = O[qt][dt] * alpha;
    }
    {
        constexpr int NS = NKT / 2;
        constexpr int DTB = (DT > 4) ? 4 : DT;
        constexpr int NDB = DT / DTB, NVB = NS * NDB;
        bf16x8 Pf[QT][NS];
#pragma unroll
        for (int s = 0; s < NS; ++s)
#pragma unroll
            for (int qt = 0; qt < QT; ++qt) {
                u32x4 w; w.x = pk2(S[qt][2 * s][0], S[qt][2 * s][1]); w.y = pk2(S[qt][2 * s][2], S[qt][2 * s][3]);
                w.z = pk2(S[qt][2 * s + 1][0], S[qt][2 * s + 1][1]); w.w = pk2(S[qt][2 * s + 1][2], S[qt][2 * s + 1][3]);
                Pf[qt][s] = __builtin_bit_cast(bf16x8, w);
            }
        const int q = li >> 2, pp = li & 3;
        LAS const unsigned char* vbase = Vs + (4 * g + q) * VSTR + 8 * pp;
        s16x4 va[2][DTB][2];
#pragma unroll
        for (int j = 0; j < DTB; ++j) { va[0][j][0] = vtr(vbase + 32 * j); va[0][j][1] = vtr(vbase + 16 * VSTR + 32 * j); }
#pragma unroll
        for (int bi = 0; bi < NVB; ++bi) {
            if (bi + 1 < NVB) {
                const int s1 = (bi + 1) / NDB, d1 = ((bi + 1) % NDB) * DTB;
#pragma unroll
                for (int j = 0; j < DTB; ++j) { va[(bi + 1) & 1][j][0] = vtr(vbase + (32 * s1) * VSTR + 32 * (d1 + j)); va[(bi + 1) & 1][j][1] = vtr(vbase + (32 * s1 + 16) * VSTR + 32 * (d1 + j)); }
            }
            __builtin_amdgcn_sched_barrier(0); __builtin_amdgcn_s_setprio(1);
            const int s = bi / NDB, d0 = (bi % NDB) * DTB;
#pragma unroll
            for (int j = 0; j < DTB; ++j) {
                const s16x4 a1 = va[bi & 1][j][0], a2 = va[bi & 1][j][1];
                const bf16x8 vf = (bf16x8){a1[0], a1[1], a1[2], a1[3], a2[0], a2[1], a2[2], a2[3]};
#pragma unroll
                for (int qt = 0; qt < QT; ++qt) O[qt][d0 + j] = __builtin_amdgcn_mfma_f32_16x16x32_bf16(vf, Pf[qt][s], O[qt][d0 + j], 0, 0, 0);
            }
__builtin_amdgcn_s_setprio(0); __builtin_amdgcn_sched_barrier(0);
        }
    }
}

__device__ __forceinline__ float rcp_(float x) { return __builtin_amdgcn_rcpf(x); }
__device__ __forceinline__ float sigmoidf_(float x) { return rcp_(1.0f + ex2(-LOG2E * x)); }
__device__ __forceinline__ float gelu_tanh(float x) { const float y = 0.7978845608028654f * (x + 0.044715f * x * x * x); const float t = 1.0f - 2.0f * rcp_(1.0f + ex2((2.0f * LOG2E) * y)); return 0.5f * x * (1.0f + t); }
__device__ __forceinline__ float one_minus_exp(float x) {
    const float p = -x * (1.0f + x * (0.5f + x * ((1.0f / 6.0f) + x * ((1.0f / 24.0f) + x * ((1.0f / 120.0f) + x * (1.0f / 720.0f))))));
    const float d = 1.0f - ex2(LOG2E * x);
    return (x < -0.3f) ? d : p;
}

__device__ __forceinline__ void lru_phase(const Params& p, LAS unsigned char* lds) {
    int tid_l = threadIdx.x; asm volatile("" : "+v"(tid_l)); const int tid = tid_l, lane = tid & 63, wid = tid >> 6, li = lane & 15, g4 = lane >> 4;
    const bf16_t* Z = (const bf16_t*)(p.ws + WS_R1);
    bf16_t* Y = (bf16_t*)(p.ws + WS_Y);
    LAS float* ucf = (LAS float*)lds;
    LAS bf16_t* ucb = (LAS bf16_t*)(lds + 32768);
    LAS bf16_t* wcat = (LAS bf16_t*)(lds + 32768 + 18432);
    LAS float* af = (LAS float*)(lds + 32768 + 2 * 18432);
    LAS float* wst = (LAS float*)(lds + 32768 + 2 * 18432 + 32768);
    LAS float* carry = wst + 1024;
    for (int unit = blockIdx.x; unit < NB * 8; unit += gridDim.x) {
        const int b = unit >> 3, gb = unit & 7;
        __syncthreads();
        for (int idx = tid; idx < 64 * 128; idx += 512) {
            const int n = idx & 127, c = idx >> 7;
            const float w = (n < 64) ? p.in[6][((size_t)gb * 64 + c) * 64 + n] : p.in[8][((size_t)gb * 64 + c) * 64 + (n - 64)];
            wcat[n * 72 + c] = (bf16_t)f2bf(w);
        }
        if (tid < 128) carry[tid] = 0.f;
        const int ch = gb * 64 + lane;
        const float cw0 = p.in[4][0 * 512 + ch], cw1 = p.in[4][1 * 512 + ch], cw2 = p.in[4][2 * 512 + ch], cw3 = p.in[4][3 * 512 + ch], cb = p.in[5][ch];
        float ba[4], bi[4], sp8[4];
#pragma unroll
        for (int nt = 0; nt < 4; ++nt) {
            const int d = gb * 64 + 16 * nt + li;
            ba[nt] = p.in[7][d]; bi[nt] = p.in[9][d];
            const float lam = p.in[10][d];
            sp8[nt] = 8.0f * (fmaxf(-lam, 0.f) + log1pf(expf(-fabsf(lam))));
        }
        __syncthreads();
        const bf16_t* zb = Z + (size_t)b * SEQ * ABN;
        unsigned un[10];
        {
            const int tw = 16 * wid;
#pragma unroll
            for (int j = 0; j < 10; ++j) {
                const int r0 = tw - 3 + 2 * j, r1 = r0 + 1;
                const unsigned a = (r0 >= 0) ? zb[(size_t)r0 * ABN + ch] : 0u;
                const unsigned bb = (j < 9 && r1 >= 0) ? zb[(size_t)r1 * ABN + ch] : 0u;
                un[j] = a | (bb << 16);
            }
        }
        for (int tc = 0; tc < SEQ / 128; ++tc) {
            const int t0 = tc * 128, tw = t0 + 16 * wid;
            unsigned uq[10], gq[8];
#pragma unroll
            for (int j = 0; j < 10; ++j) uq[j] = un[j];
#pragma unroll
            for (int j = 0; j < 8; ++j) { const unsigned a = zb[(size_t)(tw + 2 * j) * ABN + 512 + ch], bb = zb[(size_t)(tw + 2 * j + 1) * ABN + 512 + ch]; gq[j] = a | (bb << 16); }
            if (tc + 1 < SEQ / 128) {
#pragma unroll
                for (int j = 0; j < 10; ++j) {
                    const unsigned a = zb[(size_t)(tw + 128 - 3 + 2 * j) * ABN + ch];
                    const unsigned bb = (j < 9) ? zb[(size_t)(tw + 128 - 3 + 2 * j + 1) * ABN + ch] : 0u;
                    un[j] = a | (bb << 16);
                }
            }
#define UQ(k) (((k) & 1) ? __uint_as_float(uq[(k) >> 1] & 0xffff0000u) : __uint_as_float(uq[(k) >> 1] << 16))
#define GQ(k) (((k) & 1) ? __uint_as_float(gq[(k) >> 1] & 0xffff0000u) : __uint_as_float(gq[(k) >> 1] << 16))
            {
#pragma unroll
                for (int i = 0; i < 16; ++i) {
                    const float uc = cb + cw0 * UQ(i) + cw1 * UQ(i + 1) + cw2 * UQ(i + 2) + cw3 * UQ(i + 3);
                    const int r = 16 * wid + i;
                    ucf[r * 64 + lane] = uc; ucb[r * 72 + lane] = (bf16_t)f2bf(uc);
                }
            }
            __syncthreads();
            {
                f32x4 acc[8];
                bf16x8 af_[2];
#pragma unroll
                for (int ks = 0; ks < 2; ++ks) af_[ks] = *(LAS const bf16x8*)((LAS const unsigned char*)ucb + ((16 * wid + li) * 72 + 32 * ks + 8 * g4) * 2);
#pragma unroll
                for (int nt = 0; nt < 8; ++nt) {
                    acc[nt] = (f32x4){0.f, 0.f, 0.f, 0.f};
#pragma unroll
                    for (int ks = 0; ks < 2; ++ks) {
                        const bf16x8 bfr = *(LAS const bf16x8*)((LAS const unsigned char*)wcat + ((16 * nt + li) * 72 + 32 * ks + 8 * g4) * 2);
                        acc[nt] = __builtin_amdgcn_mfma_f32_16x16x32_bf16(af_[ks], bfr, acc[nt], 0, 0, 0);
                    }
                }
#pragma unroll
                for (int nt = 0; nt < 4; ++nt)
#pragma unroll
                    for (int e = 0; e < 4; ++e) {
                        const int r = 16 * wid + 4 * g4 + e, d = 16 * nt + li;
                        const float rg = sigmoidf_(acc[nt][e] + ba[nt]), ig = sigmoidf_(acc[nt + 4][e] + bi[nt]);
                        const float la = -sp8[nt] * rg;
                        const float a = ex2(LOG2E * la);
                        const float mult = __builtin_amdgcn_sqrtf(fmaxf(one_minus_exp(2.0f * la), 0.f));
                        const float uc = ucf[r * 64 + d];
                        ucf[r * 64 + d] = mult * ig * uc;
                        af[r * 64 + d] = a;
                    }
            }
            __syncthreads();
            {
                float A = 1.f, H = 0.f;
#pragma unroll 4
                for (int i = 0; i < 16; ++i) { const int r = 16 * wid + i; const float a = af[r * 64 + lane], x = ucf[r * 64 + lane]; H = a * H + x; A *= a; }
                wst[(wid * 2 + 0) * 64 + lane] = A; wst[(wid * 2 + 1) * 64 + lane] = H;
            }
            __syncthreads();
            {
                float h = carry[(tc & 1) * 64 + lane];
                for (int w = 0; w < wid; ++w) h = wst[(w * 2 + 0) * 64 + lane] * h + wst[(w * 2 + 1) * 64 + lane];
#pragma unroll
                for (int i = 0; i < 16; ++i) {
                    const int r = 16 * wid + i;
                    const float a = af[r * 64 + lane], x = ucf[r * 64 + lane];
                    h = a * h + x;
                    Y[((size_t)b * SEQ + tw + i) * DM + ch] = (bf16_t)f2bf(h * gelu_tanh(GQ(i)));
                }
                if (wid == 7) carry[((tc + 1) & 1) * 64 + lane] = h;
            }
            __syncthreads();
        }
    }
}

struct FoxFn {
    LAS const float* cs; int key0, row0; bool domask;
    __device__ __forceinline__ f32x4 init(int kt) const { return *(LAS const f32x4*)(cs + 16 * kt + (key0 & 12)); }
    __device__ __forceinline__ f32x4 apply(f32x4 s, int qt, int kt) const {
        f32x4 t = s;
        if (domask) {
            const int row = row0 + 16 * qt, kb = key0 + 16 * kt;
#pragma unroll
            for (int e = 0; e < 4; ++e) if (kb + e > row) t[e] = -INFINITY;
        }
        return t;
    }
};

__device__ __forceinline__ void fox_phase(const Params& p, LAS unsigned char* lds) {
    int tid_l = threadIdx.x; asm volatile("" : "+v"(tid_l)); const int tid = tid_l, lane = tid & 63, wid = __builtin_amdgcn_readfirstlane(tid >> 6), li = lane & 15, g = lane >> 4;
    const bf16_t* Z = (const bf16_t*)(p.ws + WS_R1);
    bf16_t* Y = (bf16_t*)(p.ws + WS_Y);
    const float* cs2 = (const float*)(p.ws + WS_CS);
    LAS unsigned char* Ks = lds;
    LAS unsigned char* Vs = lds + 20480;
    LAS float* csl = (LAS float*)(lds + 40960);
    const int nunits = NB * 8 * 4;
    const bool xmap = (gridDim.x == 256);
    const int vcu = __builtin_amdgcn_readfirstlane(*(volatile LAS int*)(lds + LDS_BYTES - 48));
    for (int unit = blockIdx.x; unit < nunits; unit += gridDim.x) {
        int bh = unit >> 2, pair = unit & 3;
        if (xmap) { bh = (vcu & 7) * 32 + (vcu >> 3); pair = unit >> 8; }
        const int b = bh >> 3, h = bh & 7;
        const bf16_t* zb = Z + (size_t)b * SEQ * ABN;
        for (int half = 0; half < 2; ++half) {
            const int qblk = half ? (7 - pair) : pair;
            const int q0 = qblk * 256, rw0 = q0 + 32 * wid;
            bf16x8 Qf[2][2];
#pragma unroll
            for (int qt = 0; qt < 2; ++qt)
#pragma unroll
                for (int ks = 0; ks < 2; ++ks) Qf[qt][ks] = *(const bf16x8*)(zb + (size_t)(rw0 + 16 * qt + li) * ABN + 1024 + 64 * h + 32 * ks + 8 * g);
            f32x4 O[2][4]; float mrow[2], lsum[2];
#pragma unroll
            for (int qt = 0; qt < 2; ++qt) { mrow[qt] = -INFINITY; lsum[qt] = 0.f;
#pragma unroll
                for (int dt = 0; dt < 4; ++dt) O[qt][dt] = (f32x4){0.f, 0.f, 0.f, 0.f}; }
            const int nst = 2 * (qblk + 1);
            u32x4 rk[2], rv[2]; float rc = 0.f;
#pragma unroll
            for (int i = 0; i < 2; ++i) { const int c = tid + 512 * i, row = c >> 3, ch = c & 7; const bf16_t* src = zb + (size_t)row * ABN + 1536 + 64 * h + 8 * ch; rk[i] = *(const u32x4*)src; rv[i] = *(const u32x4*)(src + 512); }
            if (tid < 128) rc = cs2[(size_t)bh * SEQ + tid];
            for (int st = 0; st < nst; ++st) {
                const int k0 = st * 128;
                __syncthreads();
#pragma unroll
                for (int i = 0; i < 2; ++i) { const int c = tid + 512 * i, row = c >> 3, ch = c & 7; *(LAS u32x4*)(Ks + row * 160 + ch * 16) = rk[i]; *(LAS u32x4*)(Vs + row * 160 + ch * 16) = rv[i]; }
                if (tid < 128) csl[tid] = -rc;
                __syncthreads();
                if (st + 1 < nst) {
#pragma unroll
                    for (int i = 0; i < 2; ++i) { const int c = tid + 512 * i, row = c >> 3, ch = c & 7; const bf16_t* src = zb + (size_t)(k0 + 128 + row) * ABN + 1536 + 64 * h + 8 * ch; rk[i] = *(const u32x4*)src; rv[i] = *(const u32x4*)(src + 512); }
                    if (tid < 128) rc = cs2[(size_t)bh * SEQ + k0 + 128 + tid];
                }
                if (k0 <= rw0 + 31) {
                    FoxFn fn; fn.cs = csl; fn.key0 = k0 + 4 * g; fn.row0 = rw0 + li; fn.domask = (k0 + 127 > rw0);
                    attn_stage<4, 2, 4, 160, 160>(O, mrow, lsum, Qf, Ks, Vs, fn, lane);
                    if (k0 + 64 <= rw0 + 31) {
                        fn.cs = csl + 64; fn.key0 = k0 + 64 + 4 * g;
                        attn_stage<4, 2, 4, 160, 160>(O, mrow, lsum, Qf, Ks + 64 * 160, Vs + 64 * 160, fn, lane);
                    }
                }
            }
#pragma unroll
            for (int qt = 0; qt < 2; ++qt) {
                float l = lsum[qt]; l = quad_sum(l);
                const float inv = 1.0f / l;
                bf16_t* dst = Y + ((size_t)b * SEQ + rw0 + 16 * qt + li) * DM + 512 + 64 * h + 4 * g;
#pragma unroll
                for (int dt = 0; dt < 4; ++dt) { const f32x4 o = O[qt][dt] * inv; u32x2 w; w.x = pk2(o[0], o[1]); w.y = pk2(o[2], o[3]); *(u32x2*)(dst + 16 * dt) = w; }
            }
        }
    }
    __syncthreads();
}

struct BandFn {
    __device__ __forceinline__ f32x4 init(int) const { return (f32x4){0.f, 0.f, 0.f, 0.f}; }
    int jk0, jq, maxd; bool domask;
    __device__ __forceinline__ f32x4 apply(f32x4 s, int qt, int kt) const {
        f32x4 t = s;
        if (!domask) return t;
#pragma unroll
        for (int e = 0; e < 4; ++e) { const int jk = jk0 + 16 * kt + e, d = jq + 16 * qt - jk; if (jk < 0 || d < 0 || d > maxd) t[e] = -INFINITY; }
        return t;
    }
};

template <int QT>
__device__ __forceinline__ void band_job(const bf16_t* zb, int qcol, int kcol, int vcol, int dil, int r, int jq0, int maxd, int T0, bool first,
                                         LAS unsigned char* wl, LAS float* Ost, LAS float* mst, LAS float* lst, int lane) {
    const int li = lane & 15, g = lane >> 4, q4 = li >> 2, pp = li & 3;
    const int jks = jq0 + 16 * QT - 160;
    u32x4 rvA[4], rvB[4];
#define BAND_VLOAD(dst, s) do { _Pragma("unroll") for (int i = 0; i < 4; ++i) { const int pc = lane + 64 * i, row = pc >> 3, ch = pc & 7, jk = jks + 32 * (s) + row; \
        dst[i] = *(const u32x4*)(zb + (size_t)((jk < 0 ? 0 : jk) * dil + r) * CDN + vcol + 8 * ch); } } while (0)
#define BAND_VSTORE(src, s) do { LAS unsigned char* vb_ = wl + ((s) & 1) * 5120; _Pragma("unroll") for (int i = 0; i < 4; ++i) { const int pc = lane + 64 * i, row = pc >> 3, ch = pc & 7; *(LAS u32x4*)(vb_ + row * 160 + ch * 16) = src[i]; } } while (0)
    BAND_VLOAD(rvA, 0); BAND_VLOAD(rvB, 1);
    bf16x8 Qf[QT][2];
#pragma unroll
    for (int qt = 0; qt < QT; ++qt)
#pragma unroll
        for (int ks = 0; ks < 2; ++ks) Qf[qt][ks] = *(const bf16x8*)(zb + (size_t)((jq0 + 16 * qt + li) * dil + r) * CDN + qcol + 32 * ks + 8 * g);
    f32x4 S[QT][10];
#pragma unroll
    for (int half = 0; half < 2; ++half) {
        bf16x8 kf[5][2];
#pragma unroll
        for (int k5 = 0; k5 < 5; ++k5) {
            const int jk = jks + 16 * (5 * half + k5) + li;
#pragma unroll
            for (int ks = 0; ks < 2; ++ks) {
                kf[k5][ks] = *(const bf16x8*)(zb + (size_t)((jk < 0 ? 0 : jk) * dil + r) * CDN + kcol + 32 * ks + 8 * g);
            }
        }
#pragma unroll
        for (int k5 = 0; k5 < 5; ++k5)
#pragma unroll
            for (int qt = 0; qt < QT; ++qt) {
                f32x4 acc = (f32x4){0.f, 0.f, 0.f, 0.f};
#pragma unroll
                for (int ks = 0; ks < 2; ++ks) acc = __builtin_amdgcn_mfma_f32_16x16x32_bf16(kf[k5][ks], Qf[qt][ks], acc, 0, 0, 0);
                S[qt][5 * half + k5] = acc;
            }
    }
    const bool early = (jks < 0);
#pragma unroll
    for (int kt = 0; kt < 10; ++kt) {
        if (kt < 2 || kt >= 8 || early) {
#pragma unroll
            for (int qt = 0; qt < QT; ++qt)
#pragma unroll
                for (int e = 0; e < 4; ++e) { const int jk = jks + 16 * kt + 4 * g + e, d = jq0 + 16 * qt + li - jk; if (jk < 0 || d < 0 || d > maxd) S[qt][kt][e] = -INFINITY; }
        }
    }
    float mrow[QT], lsum[QT];
#pragma unroll
    for (int qt = 0; qt < QT; ++qt) {
        float mx = -INFINITY;
#pragma unroll
        for (int kt = 0; kt < 10; ++kt) { mx = max3f(mx, S[qt][kt][0], S[qt][kt][1]); mx = max3f(mx, S[qt][kt][2], S[qt][kt][3]); }
        mx = quad_max(mx);
        float ps = 0.f;
#pragma unroll
        for (int kt = 0; kt < 10; ++kt)
#pragma unroll
            for (int e = 0; e < 4; ++e) { const float pv = ex2(S[qt][kt][e] - mx); S[qt][kt][e] = pv; ps += pv; }
        mrow[qt] = mx; lsum[qt] = ps;
    }
    f32x4 O[QT][4];
#pragma unroll
    for (int qt = 0; qt < QT; ++qt)
#pragma unroll
        for (int dt = 0; dt < 4; ++dt) O[qt][dt] = (f32x4){0.f, 0.f, 0.f, 0.f};
#pragma unroll
    for (int s = 0; s < 5; ++s) {
        if (s & 1) BAND_VSTORE(rvB, s); else BAND_VSTORE(rvA, s);
        if (s + 2 < 5) { if (s & 1) BAND_VLOAD(rvB, s + 2); else BAND_VLOAD(rvA, s + 2); }
        bf16x8 Pf[QT];
#pragma unroll
        for (int qt = 0; qt < QT; ++qt) {
            u32x4 w; w.x = pk2(S[qt][2 * s][0], S[qt][2 * s][1]); w.y = pk2(S[qt][2 * s][2], S[qt][2 * s][3]);
            w.z = pk2(S[qt][2 * s + 1][0], S[qt][2 * s + 1][1]); w.w = pk2(S[qt][2 * s + 1][2], S[qt][2 * s + 1][3]);
            Pf[qt] = __builtin_bit_cast(bf16x8, w);
        }
        LAS const unsigned char* Vs = wl + (s & 1) * 5120;
#pragma unroll
        for (int dt = 0; dt < 4; ++dt) {
            LAS const unsigned char* vp = Vs + (4 * g + q4) * 160 + (16 * dt + 4 * pp) * 2;
            const s16x4 a1 = vtr(vp), a2 = vtr(vp + 16 * 160);
            const bf16x8 vf = (bf16x8){a1[0], a1[1], a1[2], a1[3], a2[0], a2[1], a2[2], a2[3]};
#pragma unroll
            for (int qt = 0; qt < QT; ++qt) O[qt][dt] = __builtin_amdgcn_mfma_f32_16x16x32_bf16(vf, Pf[qt], O[qt][dt], 0, 0, 0);
        }
    }
#undef BAND_VLOAD
#undef BAND_VSTORE
#pragma unroll
    for (int qt = 0; qt < QT; ++qt) {
        float l = lsum[qt]; l = quad_sum(l);
        const int tl = (jq0 + 16 * qt + li) * dil + r - T0;
        float fo = 0.f, fn_ = 1.f, mn = mrow[qt], ln = l;
        if (!first) { const float mo = mst[tl], lo = lst[tl]; mn = fmaxf(mo, mrow[qt]); fo = ex2(mo - mn); fn_ = ex2(mrow[qt] - mn); ln = lo * fo + l * fn_; }
#pragma unroll
        for (int dt = 0; dt < 4; ++dt) {
            LAS f32x4* sp = (LAS f32x4*)(Ost + tl * 64 + 16 * dt + 4 * g);
            f32x4 o = O[qt][dt] * fn_;
            if (!first) o = o + (*sp) * fo;
            *sp = o;
        }
        if (g == 0) { mst[tl] = mn; lst[tl] = ln; }
    }
}

__device__ __forceinline__ const bf16_t* zhead(const bf16_t* Z, int b, int hb) { return Z + ((size_t)(b * 36 + hb) * SEQ) * 64; }
constexpr size_t WS_P16 = WS_R1 + 320 * MiB;
constexpr size_t WS_M16 = WS_R1 + 400 * MiB;
constexpr size_t WS_L16 = WS_R1 + 404 * MiB;
__device__ __forceinline__ void d16_job(LAS const unsigned char* Kc, LAS const unsigned char* Vc, const bf16_t* qh, int r, int qt, bf16_t* Pb, float* Mb, float* Lb, int lane) {
    const int li = lane & 15, g = lane >> 4, q4 = li >> 2, pp = li & 3;
    const int token = (16 * qt + li) * 16 + r;
    bf16x8 Qf[2];
#pragma unroll
    for (int ks = 0; ks < 2; ++ks) Qf[ks] = *(const bf16x8*)(qh + (unsigned)(token * 64 + 32 * ks + 8 * g));
    bf16x8 kf[8][2];
    LAS const unsigned char* kbase = Kc + li * 160 + 16 * g;
#pragma unroll
    for (int kt = 0; kt < 8; ++kt)
#pragma unroll
        for (int ks = 0; ks < 2; ++ks) kf[kt][ks] = *(LAS const bf16x8*)(kbase + (16 * kt) * 160 + 64 * ks);
    __builtin_amdgcn_sched_barrier(0);
    f32x4 S[8];
#pragma unroll
    for (int kt = 0; kt < 8; ++kt) {
        f32x4 acc = (f32x4){0.f, 0.f, 0.f, 0.f};
#pragma unroll
        for (int ks = 0; ks < 2; ++ks) acc = __builtin_amdgcn_mfma_f32_16x16x32_bf16(kf[kt][ks], Qf[ks], acc, 0, 0, 0);
        S[kt] = acc;
    }
    float mx = -INFINITY;
#pragma unroll
    for (int kt = 0; kt < 8; ++kt) {
#pragma unroll
        for (int e = 0; e < 4; ++e) if (16 * kt + 4 * g + e > 16 * qt + li) S[kt][e] = -INFINITY;
        mx = max3f(mx, S[kt][0], S[kt][1]); mx = max3f(mx, S[kt][2], S[kt][3]);
    }
    mx = quad_max(mx);
    float ps = 0.f;
#pragma unroll
    for (int kt = 0; kt < 8; ++kt)
#pragma unroll
        for (int e = 0; e < 4; ++e) { const float pv = ex2(S[kt][e] - mx); S[kt][e] = pv; ps += pv; }
    const float l = quad_sum(ps);
    f32x4 O[4];
#pragma unroll
    for (int dt = 0; dt < 4; ++dt) O[dt] = (f32x4){0.f, 0.f, 0.f, 0.f};
    LAS const unsigned char* vbase = Vc + (4 * g + q4) * 160 + 8 * pp;
#pragma unroll
    for (int s = 0; s < 4; ++s) {
        s16x4 va[4][2];
#pragma unroll
        for (int dt = 0; dt < 4; ++dt) { va[dt][0] = vtr(vbase + (32 * s) * 160 + 32 * dt); va[dt][1] = vtr(vbase + (32 * s + 16) * 160 + 32 * dt); }
        u32x4 w; w.x = pk2(S[2 * s][0], S[2 * s][1]); w.y = pk2(S[2 * s][2], S[2 * s][3]); w.z = pk2(S[2 * s + 1][0], S[2 * s + 1][1]); w.w = pk2(S[2 * s + 1][2], S[2 * s + 1][3]);
        const bf16x8 Pf = __builtin_bit_cast(bf16x8, w);
#pragma unroll
        for (int dt = 0; dt < 4; ++dt) {
            const bf16x8 vf = (bf16x8){va[dt][0][0], va[dt][0][1], va[dt][0][2], va[dt][0][3], va[dt][1][0], va[dt][1][1], va[dt][1][2], va[dt][1][3]};
            O[dt] = __builtin_amdgcn_mfma_f32_16x16x32_bf16(vf, Pf, O[dt], 0, 0, 0);
        }
    }
    const float inv = 1.0f / l;
    bf16_t* dst = Pb + (size_t)token * 512 + 4 * g;
#pragma unroll
    for (int dt = 0; dt < 4; ++dt) { const f32x4 o = O[dt] * inv; u32x2 w2; w2.x = pk2(o[0], o[1]); w2.y = pk2(o[2], o[3]); *(u32x2*)(dst + 16 * dt) = w2; }
    if (g == 0) { Mb[(size_t)token * 8] = mx; Lb[(size_t)token * 8] = l; }
}
__device__ __forceinline__ void d16_phase(const Params& p, LAS unsigned char* lds) {
    int tid_l = threadIdx.x; asm volatile("" : "+v"(tid_l)); const int tid = tid_l, lane = tid & 63, wid = __builtin_amdgcn_readfirstlane(tid >> 6);
    const bf16_t* Z = (const bf16_t*)(p.ws + WS_R1);
    LAS unsigned char* Ks = lds;
    LAS unsigned char* Vs = lds + 40960;
    for (int bh = blockIdx.x; bh < NB * 8; bh += gridDim.x) {
        const int b = bh >> 3, h = bh & 7;
        const bf16_t* qh = zhead(Z, b, h); const bf16_t* kh_ = zhead(Z, b, 8 + h); const bf16_t* vh_ = zhead(Z, b, 16 + h);
        bf16_t* Pb = (bf16_t*)(p.ws + WS_P16) + (size_t)b * SEQ * 512 + 64 * h;
        float* Mb = (float*)(p.ws + WS_M16) + (size_t)b * SEQ * 8 + h;
        float* Lb = (float*)(p.ws + WS_L16) + (size_t)b * SEQ * 8 + h;
        u32x4 rk[4], rv[4];
#define D16_LOAD(cp) do { _Pragma("unroll") for (int i = 0; i < 4; ++i) { const int c = tid + 512 * i, row = c >> 3, ch = c & 7, token = (row & 127) * 16 + 2 * (cp) + (row >> 7); \
            const unsigned so = (unsigned)(token * 64 + 8 * ch); rk[i] = *(const u32x4*)(kh_ + so); rv[i] = *(const u32x4*)(vh_ + so); } } while (0)
        D16_LOAD(0);
        for (int cp = 0; cp < 8; ++cp) {
            __syncthreads();
#pragma unroll
            for (int i = 0; i < 4; ++i) { const int c = tid + 512 * i, row = c >> 3, ch = c & 7; *(LAS u32x4*)(Ks + row * 160 + ch * 16) = rk[i]; *(LAS u32x4*)(Vs + row * 160 + ch * 16) = rv[i]; }
            __syncthreads();
            if (cp + 1 < 8) D16_LOAD(cp + 1);
            d16_job(Ks, Vs, qh, 2 * cp, wid, Pb, Mb, Lb, lane);
            d16_job(Ks + 128 * 160, Vs + 128 * 160, qh, 2 * cp + 1, 7 - wid, Pb, Mb, Lb, lane);
        }
#undef D16_LOAD
    }
    __syncthreads();
}

__device__ __forceinline__ void swa_phase(const Params& p, LAS unsigned char* lds) {
    int tid_l = threadIdx.x; asm volatile("" : "+v"(tid_l)); const int tid = tid_l, lane = tid & 63, wid = __builtin_amdgcn_readfirstlane(tid >> 6), li = lane & 15, g = lane >> 4, q4 = li >> 2, pp = li & 3;
    const bf16_t* Z = (const bf16_t*)(p.ws + WS_R1);
    bf16_t* Y = (bf16_t*)(p.ws + WS_Y);
    LAS unsigned char* Ks = lds;
    LAS unsigned char* Vs = lds + 61440;
    const int vcu = __builtin_amdgcn_readfirstlane(*(volatile LAS int*)(lds + LDS_BYTES - 48));
    for (int unit = blockIdx.x; unit < NB * 8 * 2; unit += gridDim.x) {
        int u2 = unit;
        if (gridDim.x == 256) { const int x = vcu & 7, v = vcu >> 3, i = unit >> 8; u2 = ((x * 4 + (v >> 3)) * 8 + (v & 7)) * 2 + i; }
        const int kvh = u2 & 1, bt = u2 >> 1, b = bt >> 3, tb = bt & 7, T0 = tb * 256;
        const bf16_t* kh_ = zhead(Z, b, 32 + kvh); const bf16_t* vh_ = zhead(Z, b, 34 + kvh);
        {
            u32x4 rk[6], rv[6];
#pragma unroll
            for (int k = 0; k < 6; ++k) {
                int tok = T0 - 128 + (tid >> 3) + 64 * k; tok = tok < 0 ? 0 : tok;
                const unsigned so = (unsigned)(tok * 64 + 8 * (tid & 7));
                rk[k] = *(const u32x4*)(kh_ + so); rv[k] = *(const u32x4*)(vh_ + so);
            }
            __syncthreads();
            LAS unsigned char* lp = Ks + (tid >> 3) * 160 + (tid & 7) * 16;
#pragma unroll
            for (int k = 0; k < 6; ++k) { *(LAS u32x4*)(lp + 64 * 160 * k) = rk[k]; *(LAS u32x4*)(lp + 61440 + 64 * 160 * k) = rv[k]; }
            __syncthreads();
        }
        const bool early = (T0 == 0);
        LAS const unsigned char* kbase = Ks + (32 * wid + li) * 160 + 16 * g;
        LAS const unsigned char* vbase = Vs + (32 * wid + 4 * g + q4) * 160 + 8 * pp;
        for (int qh = 0; qh < 4; ++qh) {
            const int h8 = 4 * kvh + qh;
            const bf16_t* qb_ = zhead(Z, b, 24 + h8) + (T0 + 32 * wid) * 64;
            bf16x8 Qf[2][2];
#pragma unroll
            for (int qt = 0; qt < 2; ++qt)
#pragma unroll
                for (int ks = 0; ks < 2; ++ks) Qf[qt][ks] = *(const bf16x8*)(qb_ + (unsigned)((16 * qt + li) * 64 + 32 * ks + 8 * g));
            f32x4 S[2][10];
            {
                bf16x8 kf[2][2][2];
#pragma unroll
                for (int t = 0; t < 2; ++t)
#pragma unroll
                    for (int ks = 0; ks < 2; ++ks) kf[0][t][ks] = *(LAS const bf16x8*)(kbase + (16 * t) * 160 + 64 * ks);
#pragma unroll
                for (int kb = 0; kb < 5; ++kb) {
                    if (kb + 1 < 5) {
#pragma unroll
                        for (int t = 0; t < 2; ++t)
#pragma unroll
                            for (int ks = 0; ks < 2; ++ks) kf[(kb + 1) & 1][t][ks] = *(LAS const bf16x8*)(kbase + (16 * (2 * (kb + 1) + t)) * 160 + 64 * ks);
                    }
                    __builtin_amdgcn_sched_barrier(0); __builtin_amdgcn_s_setprio(1);
#pragma unroll
                    for (int t = 0; t < 2; ++t)
#pragma unroll
                        for (int qt = 0; qt < 2; ++qt) {
                            f32x4 acc = (f32x4){0.f, 0.f, 0.f, 0.f};
#pragma unroll
                            for (int ks = 0; ks < 2; ++ks) acc = __builtin_amdgcn_mfma_f32_16x16x32_bf16(kf[kb & 1][t][ks], Qf[qt][ks], acc, 0, 0, 0);
                            S[qt][2 * kb + t] = acc;
                        }
__builtin_amdgcn_s_setprio(0); __builtin_amdgcn_sched_barrier(0);
                }
            }
#pragma unroll
            for (int kt = 0; kt < 10; ++kt) {
                if (kt < 2 || kt >= 8 || early) {
#pragma unroll
                    for (int qt = 0; qt < 2; ++qt)
#pragma unroll
                        for (int e = 0; e < 4; ++e) { const int kr = 16 * kt + 4 * g + e - 128, d = 16 * qt + li - kr; if (d < 0 || d > 127 || T0 + 32 * wid + kr < 0) S[qt][kt][e] = -INFINITY; }
                }
            }
            const float sink2 = p.in[15][h8] * LOG2E;
            float scl[2];
            bf16x8 Pf[2][5];
#pragma unroll
            for (int qt = 0; qt < 2; ++qt) {
                float mx = -INFINITY;
#pragma unroll
                for (int kt = 0; kt < 10; ++kt) { mx = max3f(mx, S[qt][kt][0], S[qt][kt][1]); mx = max3f(mx, S[qt][kt][2], S[qt][kt][3]); }
                mx = max2f(quad_max(mx), sink2);
                float ps = 0.f;
#pragma unroll
                for (int kt = 0; kt < 10; ++kt)
#pragma unroll
                    for (int e = 0; e < 4; ++e) { const float pv = ex2(S[qt][kt][e] - mx); S[qt][kt][e] = pv; ps += pv; }
                scl[qt] = 1.0f / (quad_sum(ps) + ex2(sink2 - mx));
#pragma unroll
                for (int s = 0; s < 5; ++s) {
                    u32x4 w; w.x = pk2(S[qt][2 * s][0], S[qt][2 * s][1]); w.y = pk2(S[qt][2 * s][2], S[qt][2 * s][3]);
                    w.z = pk2(S[qt][2 * s + 1][0], S[qt][2 * s + 1][1]); w.w = pk2(S[qt][2 * s + 1][2], S[qt][2 * s + 1][3]);
                    Pf[qt][s] = __builtin_bit_cast(bf16x8, w);
                }
            }
            f32x4 O[2][4];
#pragma unroll
            for (int qt = 0; qt < 2; ++qt)
#pragma unroll
                for (int dt = 0; dt < 4; ++dt) O[qt][dt] = (f32x4){0.f, 0.f, 0.f, 0.f};
            {
                s16x4 va[2][4][2];
#pragma unroll
                for (int dt = 0; dt < 4; ++dt) { va[0][dt][0] = vtr(vbase + 32 * dt); va[0][dt][1] = vtr(vbase + 16 * 160 + 32 * dt); }
#pragma unroll
                for (int s = 0; s < 5; ++s) {
                    if (s + 1 < 5) {
#pragma unroll
                        for (int dt = 0; dt < 4; ++dt) { va[(s + 1) & 1][dt][0] = vtr(vbase + (32 * (s + 1)) * 160 + 32 * dt); va[(s + 1) & 1][dt][1] = vtr(vbase + (32 * (s + 1) + 16) * 160 + 32 * dt); }
                    }
                    __builtin_amdgcn_sched_barrier(0); __builtin_amdgcn_s_setprio(1);
#pragma unroll
                    for (int dt = 0; dt < 4; ++dt) {
                        const s16x4 a1 = va[s & 1][dt][0], a2 = va[s & 1][dt][1];
                        const bf16x8 vf = (bf16x8){a1[0], a1[1], a1[2], a1[3], a2[0], a2[1], a2[2], a2[3]};
#pragma unroll
                        for (int qt = 0; qt < 2; ++qt) O[qt][dt] = __builtin_amdgcn_mfma_f32_16x16x32_bf16(vf, Pf[qt][s], O[qt][dt], 0, 0, 0);
                    }
__builtin_amdgcn_s_setprio(0); __builtin_amdgcn_sched_barrier(0);
                }
            }
            bf16_t* yb_ = Y + ((size_t)b * SEQ + T0 + 32 * wid) * DM + 512 + 64 * h8;
#pragma unroll
            for (int qt = 0; qt < 2; ++qt)
#pragma unroll
                for (int dt = 0; dt < 4; ++dt) { const f32x4 o = O[qt][dt] * scl[qt]; u32x2 w; w.x = pk2(o[0], o[1]); w.y = pk2(o[2], o[3]); *(u32x2*)(yb_ + (unsigned)((16 * qt + li) * DM + 16 * dt + 4 * g)) = w; }
        }
    }
    __syncthreads();
}

constexpr size_t WS_P4 = WS_R1 + 408 * MiB, WS_M4 = WS_R1 + 480 * MiB, WS_L4 = WS_R1 + 484 * MiB;
__device__ __forceinline__ void d4_phase(const Params& p, LAS unsigned char* lds) {
    int tid_l = threadIdx.x; asm volatile("" : "+v"(tid_l)); const int tid = tid_l, lane = tid & 63, wid = __builtin_amdgcn_readfirstlane(tid >> 6), li = lane & 15, g = lane >> 4, q4 = li >> 2, pp = li & 3;
    const bf16_t* Z = (const bf16_t*)(p.ws + WS_R1);
    LAS unsigned char* Ks = lds;
    LAS unsigned char* Vs = lds + 61440;
    const int vcu = __builtin_amdgcn_readfirstlane(*(volatile LAS int*)(lds + LDS_BYTES - 48));
#define D4_PARAMS(u_, b_, hq_, r4_, T0_) int b_, hq_, r4_, T0_; { int bh_ = (u_) >> 3, sub_ = (u_) & 7; if (gridDim.x == 256) { bh_ = (vcu & 7) * 32 + (vcu >> 3); sub_ = (u_) >> 8; } \
        b_ = bh_ >> 3; hq_ = bh_ & 7; r4_ = sub_ >> 1; T0_ = (sub_ & 1) * 256; }
    u32x4 rk[6], rv[6]; bf16x8 Qn[2][2];
#define D4_FETCH(u_) do { D4_PARAMS(u_, fb, fh, fr, fT); const bf16_t* kh_ = zhead(Z, fb, 8 + fh); const bf16_t* vh_ = zhead(Z, fb, 16 + fh); \
        _Pragma("unroll") for (int k = 0; k < 6; ++k) { int j = fT - 128 + (tid >> 3) + 64 * k; j = j < 0 ? 0 : j; const unsigned so = (unsigned)((4 * j + fr) * 64 + 8 * (tid & 7)); \
            rk[k] = *(const u32x4*)(kh_ + so); rv[k] = *(const u32x4*)(vh_ + so); } \
        const bf16_t* qb_ = zhead(Z, fb, fh) + (4 * (fT + 32 * wid) + fr) * 64; \
        _Pragma("unroll") for (int qt = 0; qt < 2; ++qt) _Pragma("unroll") for (int ks = 0; ks < 2; ++ks) Qn[qt][ks] = *(const bf16x8*)(qb_ + (unsigned)(4 * (16 * qt + li) * 64 + 32 * ks + 8 * g)); } while (0)
    const int nunits = NB * 8 * 8;
    if ((int)blockIdx.x < nunits) D4_FETCH((int)blockIdx.x);
    for (int unit = blockIdx.x; unit < nunits; unit += gridDim.x) {
        D4_PARAMS(unit, b, hq, r4, T0);
        __syncthreads();
        {
            LAS unsigned char* lp = Ks + (tid >> 3) * 160 + (tid & 7) * 16;
#pragma unroll
            for (int k = 0; k < 6; ++k) { *(LAS u32x4*)(lp + 64 * 160 * k) = rk[k]; *(LAS u32x4*)(lp + 61440 + 64 * 160 * k) = rv[k]; }
        }
        bf16x8 Qf[2][2];
#pragma unroll
        for (int qt = 0; qt < 2; ++qt)
#pragma unroll
            for (int ks = 0; ks < 2; ++ks) Qf[qt][ks] = Qn[qt][ks];
        __syncthreads();
        if (unit + (int)gridDim.x < nunits) D4_FETCH(unit + (int)gridDim.x);
        const bool early = (T0 == 0);
        LAS const unsigned char* kbase = Ks + (32 * wid + li) * 160 + 16 * g;
        LAS const unsigned char* vbase = Vs + (32 * wid + 4 * g + q4) * 160 + 8 * pp;
        for (int once = 0; once < 1; ++once) {
            f32x4 S[2][10];
            {
                bf16x8 kf[2][2][2];
#pragma unroll
                for (int t = 0; t < 2; ++t)
#pragma unroll
                    for (int ks = 0; ks < 2; ++ks) kf[0][t][ks] = *(LAS const bf16x8*)(kbase + (16 * t) * 160 + 64 * ks);
#pragma unroll
                for (int kb = 0; kb < 5; ++kb) {
                    if (kb + 1 < 5) {
#pragma unroll
                        for (int t = 0; t < 2; ++t)
#pragma unroll
                            for (int ks = 0; ks < 2; ++ks) kf[(kb + 1) & 1][t][ks] = *(LAS const bf16x8*)(kbase + (16 * (2 * (kb + 1) + t)) * 160 + 64 * ks);
                    }
                    __builtin_amdgcn_sched_barrier(0); __builtin_amdgcn_s_setprio(1);
#pragma unroll
                    for (int t = 0; t < 2; ++t)
#pragma unroll
                        for (int qt = 0; qt < 2; ++qt) {
                            f32x4 acc = (f32x4){0.f, 0.f, 0.f, 0.f};
#pragma unroll
                            for (int ks = 0; ks < 2; ++ks) acc = __builtin_amdgcn_mfma_f32_16x16x32_bf16(kf[kb & 1][t][ks], Qf[qt][ks], acc, 0, 0, 0);
                            S[qt][2 * kb + t] = acc;
                        }
__builtin_amdgcn_s_setprio(0); __builtin_amdgcn_sched_barrier(0);
                }
            }
#pragma unroll
            for (int kt = 0; kt < 10; ++kt) {
                if (kt < 2 || kt >= 8 || early) {
#pragma unroll
                    for (int qt = 0; qt < 2; ++qt)
#pragma unroll
                        for (int e = 0; e < 4; ++e) { const int kr = 16 * kt + 4 * g + e - 128, d = 16 * qt + li - kr; if (d < 0 || d > 128 || T0 + 32 * wid + kr < 0) S[qt][kt][e] = -INFINITY; }
                }
            }
            float scl[2], mq[2], lq[2];
            bf16x8 Pf[2][5];
#pragma unroll
            for (int qt = 0; qt < 2; ++qt) {
                float mx = -INFINITY;
#pragma unroll
                for (int kt = 0; kt < 10; ++kt) { mx = max3f(mx, S[qt][kt][0], S[qt][kt][1]); mx = max3f(mx, S[qt][kt][2], S[qt][kt][3]); }
                mx = quad_max(mx);
                float ps = 0.f;
#pragma unroll
                for (int kt = 0; kt < 10; ++kt)
#pragma unroll
                    for (int e = 0; e < 4; ++e) { const float pv = ex2(S[qt][kt][e] - mx); S[qt][kt][e] = pv; ps += pv; }
                lq[qt] = quad_sum(ps); mq[qt] = mx; scl[qt] = 1.0f / lq[qt];
#pragma unroll
                for (int s = 0; s < 5; ++s) {
                    u32x4 w; w.x = pk2(S[qt][2 * s][0], S[qt][2 * s][1]); w.y = pk2(S[qt][2 * s][2], S[qt][2 * s][3]);
                    w.z = pk2(S[qt][2 * s + 1][0], S[qt][2 * s + 1][1]); w.w = pk2(S[qt][2 * s + 1][2], S[qt][2 * s + 1][3]);
                    Pf[qt][s] = __builtin_bit_cast(bf16x8, w);
                }
            }
            f32x4 O[2][4];
#pragma unroll
            for (int qt = 0; qt < 2; ++qt)
#pragma unroll
                for (int dt = 0; dt < 4; ++dt) O[qt][dt] = (f32x4){0.f, 0.f, 0.f, 0.f};
            {
                s16x4 va[2][4][2];
#pragma unroll
                for (int dt = 0; dt < 4; ++dt) { va[0][dt][0] = vtr(vbase + 32 * dt); va[0][dt][1] = vtr(vbase + 16 * 160 + 32 * dt); }
#pragma unroll
                for (int s = 0; s < 5; ++s) {
                    if (s + 1 < 5) {
#pragma unroll
                        for (int dt = 0; dt < 4; ++dt) { va[(s + 1) & 1][dt][0] = vtr(vbase + (32 * (s + 1)) * 160 + 32 * dt); va[(s + 1) & 1][dt][1] = vtr(vbase + (32 * (s + 1) + 16) * 160 + 32 * dt); }
                    }
                    __builtin_amdgcn_sched_barrier(0); __builtin_amdgcn_s_setprio(1);
#pragma unroll
                    for (int dt = 0; dt < 4; ++dt) {
                        const s16x4 a1 = va[s & 1][dt][0], a2 = va[s & 1][dt][1];
                        const bf16x8 vf = (bf16x8){a1[0], a1[1], a1[2], a1[3], a2[0], a2[1], a2[2], a2[3]};
#pragma unroll
                        for (int qt = 0; qt < 2; ++qt) O[qt][dt] = __builtin_amdgcn_mfma_f32_16x16x32_bf16(vf, Pf[qt][s], O[qt][dt], 0, 0, 0);
                    }
__builtin_amdgcn_s_setprio(0); __builtin_amdgcn_sched_barrier(0);
                }
            }
#pragma unroll
            for (int qt = 0; qt < 2; ++qt) {
                const size_t trow = (size_t)b * SEQ + 4 * (T0 + 32 * wid + 16 * qt + li) + r4;
                bf16_t* dst = (bf16_t*)(p.ws + WS_P4) + trow * 512 + 64 * hq + 4 * g;
#pragma unroll
                for (int dt = 0; dt < 4; ++dt) { const f32x4 o = O[qt][dt] * scl[qt]; u32x2 w; w.x = pk2(o[0], o[1]); w.y = pk2(o[2], o[3]); *(u32x2*)(dst + 16 * dt) = w; }
                if (g == 0) { ((float*)(p.ws + WS_M4))[trow * 8 + hq] = mq[qt]; ((float*)(p.ws + WS_L4))[trow * 8 + hq] = lq[qt]; }
            }
        }
    }
#undef D4_PARAMS
#undef D4_FETCH
    __syncthreads();
}

__device__ __forceinline__ void band_phase(const Params& p, LAS unsigned char* lds) {
    int tid_l = threadIdx.x; asm volatile("" : "+v"(tid_l)); const int tid = tid_l, lane = tid & 63, wid = __builtin_amdgcn_readfirstlane(tid >> 6), li = lane & 15, g = lane >> 4, q4 = li >> 2, pp = li & 3;
    const bf16_t* Z = (const bf16_t*)(p.ws + WS_R1);
    bf16_t* Y = (bf16_t*)(p.ws + WS_Y);
    LAS unsigned char* Ks = lds;
    LAS unsigned char* Vs = lds + 61440;
    const int vcu = __builtin_amdgcn_readfirstlane(*(volatile LAS int*)(lds + LDS_BYTES - 48));
#define BD_PARAMS(u_, b_, hq_, r4_, T0_) int b_, hq_, r4_, T0_; { int bt_ = (u_) >> 3; hq_ = (u_) & 7; if (gridDim.x == 256) { const int v_ = vcu >> 3; bt_ = ((vcu & 7) * 4 + (v_ >> 3)) * 8 + (v_ & 7); hq_ = (u_) >> 8; } \
        b_ = bt_ >> 3; r4_ = 0; T0_ = (bt_ & 7) * 256; }
    u32x4 rk[6], rv[6]; bf16x8 Qn[2][2];
#define BD_FETCH(u_) do { BD_PARAMS(u_, fb, fh, fr, fT); const bf16_t* kh_ = zhead(Z, fb, 8 + fh); const bf16_t* vh_ = zhead(Z, fb, 16 + fh); \
        _Pragma("unroll") for (int k = 0; k < 6; ++k) { int j = fT - 128 + (tid >> 3) + 64 * k; j = j < 0 ? 0 : j; const unsigned so = (unsigned)(j * 64 + 8 * (tid & 7)); \
            rk[k] = *(const u32x4*)(kh_ + so); rv[k] = *(const u32x4*)(vh_ + so); } \
        const bf16_t* qb_ = zhead(Z, fb, fh) + (fT + 32 * wid) * 64; \
        _Pragma("unroll") for (int qt = 0; qt < 2; ++qt) _Pragma("unroll") for (int ks = 0; ks < 2; ++ks) Qn[qt][ks] = *(const bf16x8*)(qb_ + (unsigned)((16 * qt + li) * 64 + 32 * ks + 8 * g)); } while (0)
    const int nunits = NB * 8 * 8;
    if ((int)blockIdx.x < nunits) BD_FETCH((int)blockIdx.x);
    for (int unit = blockIdx.x; unit < nunits; unit += gridDim.x) {
        BD_PARAMS(unit, b, hq, r4, T0);
        __syncthreads();
        {
            LAS unsigned char* lp = Ks + (tid >> 3) * 160 + (tid & 7) * 16;
#pragma unroll
            for (int k = 0; k < 6; ++k) { *(LAS u32x4*)(lp + 64 * 160 * k) = rk[k]; *(LAS u32x4*)(lp + 61440 + 64 * 160 * k) = rv[k]; }
        }
        bf16x8 Qf[2][2];
#pragma unroll
        for (int qt = 0; qt < 2; ++qt)
#pragma unroll
            for (int ks = 0; ks < 2; ++ks) Qf[qt][ks] = Qn[qt][ks];
        __syncthreads();
        if (unit + (int)gridDim.x < nunits) BD_FETCH(unit + (int)gridDim.x);
        const bool early = (T0 == 0);
        LAS const unsigned char* kbase = Ks + (32 * wid + li) * 160 + 16 * g;
        LAS const unsigned char* vbase = Vs + (32 * wid + 4 * g + q4) * 160 + 8 * pp;
        for (int once = 0; once < 1; ++once) {
            f32x4 S[2][10];
            {
                bf16x8 kf[2][2][2];
#pragma unroll
                for (int t = 0; t < 2; ++t)
#pragma unroll
                    for (int ks = 0; ks < 2; ++ks) kf[0][t][ks] = *(LAS const bf16x8*)(kbase + (16 * t) * 160 + 64 * ks);
#pragma unroll
                for (int kb = 0; kb < 5; ++kb) {
                    if (kb + 1 < 5) {
#pragma unroll
                        for (int t = 0; t < 2; ++t)
#pragma unroll
                            for (int ks = 0; ks < 2; ++ks) kf[(kb + 1) & 1][t][ks] = *(LAS const bf16x8*)(kbase + (16 * (2 * (kb + 1) + t)) * 160 + 64 * ks);
                    }
                    __builtin_amdgcn_sched_barrier(0); __builtin_amdgcn_s_setprio(1);
#pragma unroll
                    for (int t = 0; t < 2; ++t)
#pragma unroll
                        for (int qt = 0; qt < 2; ++qt) {
                            f32x4 acc = (f32x4){0.f, 0.f, 0.f, 0.f};
#pragma unroll
                            for (int ks = 0; ks < 2; ++ks) acc = __builtin_amdgcn_mfma_f32_16x16x32_bf16(kf[kb & 1][t][ks], Qf[qt][ks], acc, 0, 0, 0);
                            S[qt][2 * kb + t] = acc;
                        }
__builtin_amdgcn_s_setprio(0); __builtin_amdgcn_sched_barrier(0);
                }
            }
#pragma unroll
            for (int kt = 0; kt < 10; ++kt) {
                if (kt < 2 || kt >= 8 || early) {
#pragma unroll
                    for (int qt = 0; qt < 2; ++qt)
#pragma unroll
                        for (int e = 0; e < 4; ++e) { const int kr = 16 * kt + 4 * g + e - 128, d = 16 * qt + li - kr; if (d < 0 || d > 128 || T0 + 32 * wid + kr < 0) S[qt][kt][e] = -INFINITY; }
                }
            }
            float scl[2], mq[2], lq[2];
            bf16x8 Pf[2][5];
#pragma unroll
            for (int qt = 0; qt < 2; ++qt) {
                float mx = -INFINITY;
#pragma unroll
                for (int kt = 0; kt < 10; ++kt) { mx = max3f(mx, S[qt][kt][0], S[qt][kt][1]); mx = max3f(mx, S[qt][kt][2], S[qt][kt][3]); }
                mx = quad_max(mx);
                float ps = 0.f;
#pragma unroll
                for (int kt = 0; kt < 10; ++kt)
#pragma unroll
                    for (int e = 0; e < 4; ++e) { const float pv = ex2(S[qt][kt][e] - mx); S[qt][kt][e] = pv; ps += pv; }
                lq[qt] = quad_sum(ps); mq[qt] = mx; scl[qt] = 1.0f / lq[qt];
#pragma unroll
                for (int s = 0; s < 5; ++s) {
                    u32x4 w; w.x = pk2(S[qt][2 * s][0], S[qt][2 * s][1]); w.y = pk2(S[qt][2 * s][2], S[qt][2 * s][3]);
                    w.z = pk2(S[qt][2 * s + 1][0], S[qt][2 * s + 1][1]); w.w = pk2(S[qt][2 * s + 1][2], S[qt][2 * s + 1][3]);
                    Pf[qt][s] = __builtin_bit_cast(bf16x8, w);
                }
            }
            f32x4 O[2][4];
#pragma unroll
            for (int qt = 0; qt < 2; ++qt)
#pragma unroll
                for (int dt = 0; dt < 4; ++dt) O[qt][dt] = (f32x4){0.f, 0.f, 0.f, 0.f};
            {
                s16x4 va[2][4][2];
#pragma unroll
                for (int dt = 0; dt < 4; ++dt) { va[0][dt][0] = vtr(vbase + 32 * dt); va[0][dt][1] = vtr(vbase + 16 * 160 + 32 * dt); }
#pragma unroll
                for (int s = 0; s < 5; ++s) {
                    if (s + 1 < 5) {
#pragma unroll
                        for (int dt = 0; dt < 4; ++dt) { va[(s + 1) & 1][dt][0] = vtr(vbase + (32 * (s + 1)) * 160 + 32 * dt); va[(s + 1) & 1][dt][1] = vtr(vbase + (32 * (s + 1) + 16) * 160 + 32 * dt); }
                    }
                    __builtin_amdgcn_sched_barrier(0); __builtin_amdgcn_s_setprio(1);
#pragma unroll
                    for (int dt = 0; dt < 4; ++dt) {
                        const s16x4 a1 = va[s & 1][dt][0], a2 = va[s & 1][dt][1];
                        const bf16x8 vf = (bf16x8){a1[0], a1[1], a1[2], a1[3], a2[0], a2[1], a2[2], a2[3]};
#pragma unroll
                        for (int qt = 0; qt < 2; ++qt) O[qt][dt] = __builtin_amdgcn_mfma_f32_16x16x32_bf16(vf, Pf[qt][s], O[qt][dt], 0, 0, 0);
                    }
__builtin_amdgcn_s_setprio(0); __builtin_amdgcn_sched_barrier(0);
                }
            }
#pragma unroll
                for (int qt = 0; qt < 2; ++qt) {
                    const int tl = 32 * wid + 16 * qt + li;
                    const size_t trow = (size_t)b * SEQ + T0 + tl;
                    const float l16 = ((const float*)(p.ws + WS_L16))[trow * 8 + hq], m16 = ((const float*)(p.ws + WS_M16))[trow * 8 + hq];
                    const float l4 = ((const float*)(p.ws + WS_L4))[trow * 8 + hq], m4 = ((const float*)(p.ws + WS_M4))[trow * 8 + hq];
                    const bf16_t* s16 = (const bf16_t*)(p.ws + WS_P16) + trow * 512 + 64 * hq + 4 * g;
                    const bf16_t* s4 = (const bf16_t*)(p.ws + WS_P4) + trow * 512 + 64 * hq + 4 * g;
                    const float mn = max3f(m16, m4, mq[qt]);
                    const float f16 = ex2(m16 - mn) * l16, f4 = ex2(m4 - mn) * l4, f1 = ex2(mq[qt] - mn);
                    const float inv = 1.0f / (f16 + f4 + lq[qt] * f1);
                    bf16_t* dst = Y + trow * DM + 64 * hq + 4 * g;
#pragma unroll
                    for (int dt = 0; dt < 4; ++dt) {
                        const u32x2 pa = *(const u32x2*)(s16 + 16 * dt), pb = *(const u32x2*)(s4 + 16 * dt);
                        f32x4 o = O[qt][dt] * f1;
                        o[0] += __uint_as_float(pa.x << 16) * f16 + __uint_as_float(pb.x << 16) * f4; o[1] += __uint_as_float(pa.x & 0xffff0000u) * f16 + __uint_as_float(pb.x & 0xffff0000u) * f4;
                        o[2] += __uint_as_float(pa.y << 16) * f16 + __uint_as_float(pb.y << 16) * f4; o[3] += __uint_as_float(pa.y & 0xffff0000u) * f16 + __uint_as_float(pb.y & 0xffff0000u) * f4;
                        o = o * inv;
                        u32x2 w; w.x = pk2(o[0], o[1]); w.y = pk2(o[2], o[3]);
                        *(u32x2*)(dst + 16 * dt) = w;
                    }
                }
        }
    }
#undef BD_PARAMS
#undef BD_FETCH
    __syncthreads();
}

struct NoFn { __device__ __forceinline__ f32x4 init(int) const { return (f32x4){0.f, 0.f, 0.f, 0.f}; } __device__ __forceinline__ f32x4 apply(f32x4 s, int, int) const { return s; } };

__device__ __forceinline__ void xattn_phase(const Params& p, LAS unsigned char* lds, int layer) {
    int tid_l = threadIdx.x; asm volatile("" : "+v"(tid_l)); const int tid = tid_l, lane = tid & 63, wid = __builtin_amdgcn_readfirstlane(tid >> 6), li = lane & 15, g = lane >> 4;
    const bf16_t* Q = (const bf16_t*)(p.ws + WS_R1);
    const bf16_t* KV = (const bf16_t*)(p.ws + WS_KV + (size_t)layer * 32 * MiB);
    bf16_t* Y = (bf16_t*)(p.ws + WS_Y);
    LAS unsigned char* T = lds;
    const int nunits = NB * 4 * 8;
    const bool xmap = (gridDim.x == 256);
    const int vcu = __builtin_amdgcn_readfirstlane(*(volatile LAS int*)(lds + LDS_BYTES - 48));
    for (int unit = blockIdx.x; unit < nunits; unit += gridDim.x) {
        int bh = unit >> 3, qb = unit & 7;
        if (xmap) { const int x = vcu & 7, v = vcu >> 3, i = unit >> 8; bh = x * 16 + 4 * i + (v >> 3); qb = v & 7; }
        const int b = bh >> 2, h = bh & 3;
        const bf16_t* Qb = Q + ((size_t)b * SEQ + qb * 256 + 32 * wid) * DM + 256 * h;
        bf16_t* Yb = Y + ((size_t)b * SEQ + qb * 256 + 32 * wid) * DM + 256 * h;
        const unsigned qoff = (unsigned)li * DM + 8 * g;
        const bf16_t* kvb = KV + (size_t)b * MEMLEN * 2 * DM + 256 * h;
        u32x4 rr[16];
#define XA_LOAD() do { _Pragma("unroll") for (int i = 0; i < 16; ++i) { rr[i] = *(const u32x4*)gp; gp += 16 * 2 * DM; asm volatile("" : "+v"(gp)); } } while (0)
#define XA_STORE() do { _Pragma("unroll") for (int i = 0; i < 16; ++i) { *(LAS u32x4*)lp = rr[i]; lp += 16 * 544; asm volatile("" : "+v"(lp)); } } while (0)
        const bf16_t* gp = kvb + (unsigned)((tid >> 5) * 2 * DM + 8 * (tid & 31));
        LAS unsigned char* lp = T + (tid >> 5) * 544 + (tid & 31) * 16;
        asm volatile("" : "+v"(gp)); asm volatile("" : "+v"(lp));
        XA_LOAD();
        __syncthreads();
        XA_STORE();
        __syncthreads();
        f32x4 S[2][16];
#pragma unroll
        for (int qt = 0; qt < 2; ++qt)
#pragma unroll
            for (int kt = 0; kt < 16; ++kt) S[qt][kt] = (f32x4){0.f, 0.f, 0.f, 0.f};
        LAS const unsigned char* kbase = T + li * 544 + 16 * g;
#pragma unroll
        for (int kq = 0; kq < 4; ++kq) {
            bf16x8 Qf[2][2];
#pragma unroll
            for (int qt = 0; qt < 2; ++qt)
#pragma unroll
                for (int j = 0; j < 2; ++j) Qf[qt][j] = *(const bf16x8*)(Qb + (qoff + (unsigned)(16 * qt * DM + 32 * (2 * kq + j))));
            LAS const unsigned char* kp = kbase + 128 * kq;
            asm volatile("" : "+v"(kp));
            bf16x8 kf[2][2];
#pragma unroll
            for (int j = 0; j < 2; ++j) kf[0][j] = *(LAS const bf16x8*)(kp + 64 * j);
#pragma unroll
            for (int kt = 0; kt < 16; ++kt) {
                if (kt + 1 < 16) {
                    kp += 16 * 544; asm volatile("" : "+v"(kp));
#pragma unroll
                    for (int j = 0; j < 2; ++j) kf[(kt + 1) & 1][j] = *(LAS const bf16x8*)(kp + 64 * j);
                }
                __builtin_amdgcn_sched_barrier(0); __builtin_amdgcn_s_setprio(1);
#pragma unroll
                for (int j = 0; j < 2; ++j)
#pragma unroll
                    for (int qt = 0; qt < 2; ++qt) S[qt][kt] = __builtin_amdgcn_mfma_f32_16x16x32_bf16(kf[kt & 1][j], Qf[qt][j], S[qt][kt], 0, 0, 0);
__builtin_amdgcn_s_setprio(0); __builtin_amdgcn_sched_barrier(0);
            }
        }
        float linv[2];
        bf16x8 Pf[2][8];
#pragma unroll
        for (int qt = 0; qt < 2; ++qt) {
            float mx = -INFINITY;
#pragma unroll
            for (int kt = 0; kt < 16; ++kt) { mx = max3f(mx, S[qt][kt][0], S[qt][kt][1]); mx = max3f(mx, S[qt][kt][2], S[qt][kt][3]); }
            mx = quad_max(mx);
            float ps = 0.f;
#pragma unroll
            for (int kt = 0; kt < 16; ++kt)
#pragma unroll
                for (int e = 0; e < 4; ++e) { const float pv = ex2(S[qt][kt][e] - mx); S[qt][kt][e] = pv; ps += pv; }
            linv[qt] = 1.0f / quad_sum(ps);
#pragma unroll
            for (int s = 0; s < 8; ++s) {
                u32x4 w; w.x = pk2(S[qt][2 * s][0], S[qt][2 * s][1]); w.y = pk2(S[qt][2 * s][2], S[qt][2 * s][3]);
                w.z = pk2(S[qt][2 * s + 1][0], S[qt][2 * s + 1][1]); w.w = pk2(S[qt][2 * s + 1][2], S[qt][2 * s + 1][3]);
                Pf[qt][s] = __builtin_bit_cast(bf16x8, w);
            }
            __builtin_amdgcn_sched_barrier(0);
        }
        gp = kvb + (unsigned)((tid >> 5) * 2 * DM + 8 * (tid & 31) + DM); lp = T + (tid >> 5) * 544 + (tid & 31) * 16;
        asm volatile("" : "+v"(gp)); asm volatile("" : "+v"(lp));
        XA_LOAD();
        __syncthreads();
        XA_STORE();
        __syncthreads();
#undef XA_LOAD
#undef XA_STORE
        const int q4 = li >> 2, pp = li & 3;
        LAS const unsigned char* vbase = T + (4 * g + q4) * 544 + 8 * pp;
#pragma unroll
        for (int dh = 0; dh < 2; ++dh) {
            f32x4 O[2][8];
#pragma unroll
            for (int qt = 0; qt < 2; ++qt)
#pragma unroll
                for (int dt = 0; dt < 8; ++dt) O[qt][dt] = (f32x4){0.f, 0.f, 0.f, 0.f};
            s16x4 va[2][4][2];
            LAS const unsigned char* vp = vbase + 32 * (8 * dh);
            asm volatile("" : "+v"(vp));
#pragma unroll
            for (int j = 0; j < 4; ++j) { va[0][j][0] = vtr(vp + 32 * j); va[0][j][1] = vtr(vp + 16 * 544 + 32 * j); }
#pragma unroll
            for (int bi = 0; bi < 16; ++bi) {
                if (bi + 1 < 16) {
                    if (((bi + 1) & 1) == 0) { vp += 32 * 544; asm volatile("" : "+v"(vp)); }
                    const int d1 = 4 * ((bi + 1) & 1);
#pragma unroll
                    for (int j = 0; j < 4; ++j) { va[(bi + 1) & 1][j][0] = vtr(vp + 32 * (d1 + j)); va[(bi + 1) & 1][j][1] = vtr(vp + 16 * 544 + 32 * (d1 + j)); }
                }
                __builtin_amdgcn_sched_barrier(0); __builtin_amdgcn_s_setprio(1);
                const int s = bi >> 1, d0 = 4 * (bi & 1);
#pragma unroll
                for (int j = 0; j < 4; ++j) {
                    const s16x4 a1 = va[bi & 1][j][0], a2 = va[bi & 1][j][1];
                    const bf16x8 vf = (bf16x8){a1[0], a1[1], a1[2], a1[3], a2[0], a2[1], a2[2], a2[3]};
#pragma unroll
                    for (int qt = 0; qt < 2; ++qt) O[qt][d0 + j] = __builtin_amdgcn_mfma_f32_16x16x32_bf16(vf, Pf[qt][s], O[qt][d0 + j], 0, 0, 0);
                }
__builtin_amdgcn_s_setprio(0); __builtin_amdgcn_sched_barrier(0);
            }
#pragma unroll
            for (int qt = 0; qt < 2; ++qt) {
                bf16_t* dst = Yb + ((unsigned)li * DM + (unsigned)(16 * qt * DM + 128 * dh) + 4 * g);
#pragma unroll
                for (int dt = 0; dt < 8; ++dt) { const f32x4 o = O[qt][dt] * linv[qt]; u32x2 w; w.x = pk2(o[0], o[1]); w.y = pk2(o[2], o[3]); *(u32x2*)(dst + 16 * dt) = w; }
            }
        }
    }
    __syncthreads();
}

__device__ __forceinline__ void final_phase(const Params& p) {
    int tid_l = threadIdx.x; asm volatile("" : "+v"(tid_l)); const int tid = tid_l, lane = tid & 63, wid = tid >> 6;
    const float* ssq = (const float*)(p.ws + WS_SSQ);
    const bf16_t* hb = (const bf16_t*)(p.ws + WS_HB);
    const int gw = blockIdx.x * 8 + wid, NGW = gridDim.x * 8;
    for (int row = gw; row < MTOK; row += NGW) {
        const float rs = pg8::row_rstd(ssq, row);
#pragma unroll
        for (int i = 0; i < 2; ++i) {
            const int c0 = 8 * (lane + 64 * i);
            const u32x4 bw = *(const u32x4*)(hb + (size_t)row * DM + c0);
            const f32x4 g0 = *(const f32x4*)(p.in[25] + c0), g1 = *(const f32x4*)(p.in[25] + c0 + 4);
            f32x4 o0, o1;
            o0[0] = __uint_as_float(bw.x << 16) * rs * g0[0]; o0[1] = __uint_as_float(bw.x & 0xffff0000u) * rs * g0[1];
            o0[2] = __uint_as_float(bw.y << 16) * rs * g0[2]; o0[3] = __uint_as_float(bw.y & 0xffff0000u) * rs * g0[3];
            o1[0] = __uint_as_float(bw.z << 16) * rs * g1[0]; o1[1] = __uint_as_float(bw.z & 0xffff0000u) * rs * g1[1];
            o1[2] = __uint_as_float(bw.w << 16) * rs * g1[2]; o1[3] = __uint_as_float(bw.w & 0xffff0000u) * rs * g1[3];
            f32x4* dst = (f32x4*)(p.out + (size_t)row * DM + c0);
            __builtin_nontemporal_store(o0, dst); __builtin_nontemporal_store(o1, dst + 1);
        }
    }
}

#define XB_TMO      128
#define XB_XCNT(j)  (256  + 64 * (j))
#define XB_XSUB(j)  (1280 + 64 * (j))
#define XB_XGEN(j)  (2304 + 64 * (j))
#define XB_TOP      3328
#define XB_TOPGEN   3392
#define XCD_BAR_WORDS 3456
#define XB_SPIN_CAP (1u << 18)

__device__ __forceinline__ unsigned xb_ld(unsigned* p)              { return __hip_atomic_load(p, __ATOMIC_RELAXED, __HIP_MEMORY_SCOPE_AGENT); }
__device__ __forceinline__ unsigned xb_add(unsigned* p, unsigned v) { return __hip_atomic_fetch_add(p, v, __ATOMIC_RELAXED, __HIP_MEMORY_SCOPE_AGENT); }
__device__ __forceinline__ unsigned xb_xcc_id() { return (unsigned)__builtin_amdgcn_s_getreg((3 << 11) | 20) & 0xFu; }
#define XB_SPIN(cond, bar) do { unsigned _sp = 0; while (cond) { __builtin_amdgcn_s_sleep(1); \
    if ((++_sp & 255u) == 0u) { if (xb_ld(&(bar)[XB_TMO])) break; if (_sp > XB_SPIN_CAP) { atomicAdd(&(bar)[XB_TMO], 1u); break; } } } } while (0)

struct XcdBarrier {
    unsigned* bar; unsigned x;
    volatile LAS unsigned* st;
};

__device__ __forceinline__ XcdBarrier xcd_barrier_post(unsigned* bar, volatile LAS unsigned* st) {
    XcdBarrier b; b.bar = bar; b.x = xb_xcc_id(); b.st = st;
    if (threadIdx.x == 0) (void)xb_add(&bar[XB_XCNT(b.x)], 1u);
    return b;
}
__device__ __forceinline__ void xcd_barrier_complete(unsigned* bar, unsigned x, unsigned& nloc, unsigned& nx) {
    const unsigned G = gridDim.x * gridDim.y * gridDim.z;
    unsigned sum, cnt, mine, sp = 0u;
    for (;;) {
        sum = 0u; cnt = 0u; mine = 0u;
#pragma unroll
        for (unsigned j = 0; j < 16; ++j) { const unsigned c = xb_ld(&bar[XB_XCNT(j)]); sum += c; cnt += (c > 0u) ? 1u : 0u; mine = (j == x) ? c : mine; }
        if (sum == G) break;
        __builtin_amdgcn_s_sleep(1);
        if ((++sp & 255u) == 0u) { if (xb_ld(&bar[XB_TMO])) break; if (sp > XB_SPIN_CAP) { atomicAdd(&bar[XB_TMO], 1u); break; } }
    }
    nloc = mine > 0u ? mine : 1u; nx = cnt > 0u ? cnt : 1u;
}

__device__ __forceinline__ void xcd_barrier(const XcdBarrier& b) {
    asm volatile("s_waitcnt vmcnt(0)" ::: "memory");
    __syncthreads();
    if (threadIdx.x == 0) {
        unsigned* bar = b.bar;
        __builtin_amdgcn_s_waitcnt(0);
        unsigned nloc = b.st[0], nx = b.st[1];
        if (nloc == 0u) { xcd_barrier_complete(bar, b.x, nloc, nx); b.st[0] = nloc; b.st[1] = nx; }
        const unsigned old = xb_add(&bar[XB_XSUB(b.x)], 1u);
        const unsigned gen = old / nloc;
        if (old + 1u == (gen + 1u) * nloc) {
            __builtin_amdgcn_fence(__ATOMIC_RELEASE, "agent");
            asm volatile("s_waitcnt vmcnt(0)" ::: "memory");
            const unsigned og = xb_add(&bar[XB_TOP], 1u);
            const unsigned tg = og / nx;
            if (og + 1u == (tg + 1u) * nx) xb_add(&bar[XB_TOPGEN], 1u);
            else XB_SPIN(xb_ld(&bar[XB_TOPGEN]) == tg, bar);
            __builtin_amdgcn_fence(__ATOMIC_ACQUIRE, "agent");
            xb_add(&bar[XB_XGEN(b.x)], 1u);
            asm volatile("s_waitcnt vmcnt(0)" ::: "memory");
        } else {
            XB_SPIN(xb_ld(&bar[XB_XGEN(b.x)]) == gen, bar);
            __builtin_amdgcn_fence(__ATOMIC_ACQUIRE, "agent");
            asm volatile("s_waitcnt vmcnt(0)" ::: "memory");
        }
    }
    __syncthreads();
}

template <class Epi>
__device__ __forceinline__ void run_gemm(LAS unsigned char* lds, const bf16_t* A, const bf16_t* Bt, int M, int N, int K, const Epi& E) {
    pg8::Gemm g{A, Bt, M, N, K};
    const int vcu = __builtin_amdgcn_readfirstlane(*(volatile LAS int*)(lds + LDS_BYTES - 48));
    pg8::StaticOrder S; S.init(M, N, (int)gridDim.x, vcu);
    pg8::gemm_phase<Epi, pg8::StaticOrder, true, true>(lds, g, S, E);
    __syncthreads();
}

__global__ void __launch_bounds__(512, 2) mega_fwd(Params p) {
    extern __shared__ __attribute__((aligned(16))) unsigned char lds_raw[];
    LAS unsigned char* lds = (LAS unsigned char*)lds_raw;
    cg::grid_group grid = cg::this_grid();
    volatile LAS unsigned* bst = (volatile LAS unsigned*)(lds + LDS_BYTES - 64);
    if (threadIdx.x < 2) bst[threadIdx.x] = 0u;
    __syncthreads();
    const XcdBarrier xbar = xcd_barrier_post((unsigned*)(p.ws + WS_BAR), bst);
    volatile LAS int* vslot = (volatile LAS int*)(lds + LDS_BYTES - 48);
    unsigned* census = (unsigned*)(p.ws + WS_BAR + 16384);
    if (threadIdx.x == 0) { const unsigned mx_ = hw_xcc_id() & 7u; vslot[1] = (int)mx_; vslot[2] = (int)__hip_atomic_fetch_add(census + 64 * mx_, 1u, __ATOMIC_RELAXED, __HIP_MEMORY_SCOPE_AGENT); }
    unsigned char* ws = p.ws;
    bf16_t* hb = (bf16_t*)(ws + WS_HB);
    float* ssq = (float*)(ws + WS_SSQ);
    bf16_t* R1 = (bf16_t*)(ws + WS_R1);
    bf16_t* Y = (bf16_t*)(ws + WS_Y);

    p0_prologue(p, lds);
#if PROBE_DUP == 4
    p0_prologue(p, lds);
#endif
    if (p.out == nullptr) grid.sync();
    xcd_barrier(xbar);
    if (threadIdx.x == 0) {
        unsigned v = 0; const unsigned my_x = (unsigned)vslot[1], my_rank = (unsigned)vslot[2];
#pragma unroll 1
        for (unsigned x = 0; x < 8; ++x) { const unsigned n = __hip_atomic_load(census + 64 * x, __ATOMIC_RELAXED, __HIP_MEMORY_SCOPE_AGENT); v += (n < my_rank ? n : my_rank) + ((x < my_x && n > my_rank) ? 1u : 0u); }
        vslot[0] = (int)v;
    }
    __syncthreads();
    fox_cumsum(p);
    __syncthreads();
    for (int l = 0; l < 2; ++l) {
        pg8::EpiScale<0> E{(bf16_t*)(ws + WS_KV + (size_t)l * 32 * MiB), 2 * DM, nullptr};
        run_gemm(lds, (const bf16_t*)(ws + WS_MEMN + (size_t)l * 16 * MiB), (const bf16_t*)(ws + WS_WKV + (size_t)l * 4 * MiB), MMEM, 2 * DM, DM, E);
    }
    for (int layer = 0; layer < 2; ++layer) {
        if (layer == 0) {
            pg8::EpiScale<0> E{R1, ABN, ssq};
            run_gemm(lds, hb, (const bf16_t*)(ws + WS_WIN0), MTOK, ABN, DM, E);
            xcd_barrier(xbar);
            lru_phase(p, lds);
#if PROBE_DUP == 1
            lru_phase(p, lds);
#endif
            fox_phase(p, lds);
#if PROBE_DUP == 2
            fox_phase(p, lds);
#endif
            xcd_barrier(xbar);
            pg8::EpiResid E2{hb, ssq};
            run_gemm(lds, Y, (const bf16_t*)(ws + WS_WOUT0), MTOK, DM, DM, E2);
        } else {
            pg8::EpiRope E{R1, ssq, (const f32x2*)(ws + WS_ROPE)};
            run_gemm(lds, hb, (const bf16_t*)(ws + WS_WIN1), MTOK, CDN, DM, E);
#if PROBE_DUP == 8
            run_gemm(lds, hb, (const bf16_t*)(ws + WS_WIN1), MTOK, CDN, DM, E);
#endif
            xcd_barrier(xbar);
            d16_phase(p, lds);
            d4_phase(p, lds);
            swa_phase(p, lds);
#if PROBE_DUP == 14
            d16_phase(p, lds);
            d4_phase(p, lds);
            swa_phase(p, lds);
#endif
            xcd_barrier(xbar);
#if PROBE_DUP == 13
            swa_phase(p, lds);
#endif
            band_phase(p, lds);
#if PROBE_DUP == 3
            band_phase(p, lds, 1);
#endif
            xcd_barrier(xbar);
            pg8::EpiResid E2{hb, ssq};
            run_gemm(lds, Y, (const bf16_t*)(ws + WS_WOUT1), MTOK, DM, DM, E2);
        }
        xcd_barrier(xbar);
        {
            pg8::EpiScale<0> E{R1, DM, ssq};
            run_gemm(lds, hb, (const bf16_t*)(ws + WS_WQ + (size_t)layer * 2 * MiB), MTOK, DM, DM, E);
#if PROBE_DUP == 7
            run_gemm(lds, hb, (const bf16_t*)(ws + WS_WQ + (size_t)layer * 2 * MiB), MTOK, DM, DM, E);
#endif
            xcd_barrier(xbar);
            xattn_phase(p, lds, layer);
#if PROBE_DUP == 5
            xattn_phase(p, lds, layer);
#endif
            xcd_barrier(xbar);
            pg8::EpiResid E2{hb, ssq};
            run_gemm(lds, Y, (const bf16_t*)(ws + WS_WO + (size_t)layer * 2 * MiB), MTOK, DM, DM, E2);
        }
        xcd_barrier(xbar);
        {
            pg8::EpiScale<1> E{R1, DFF, ssq};
            run_gemm(lds, hb, (const bf16_t*)(ws + WS_WUP + (size_t)layer * 8 * MiB), MTOK, DFF, DM, E);
#if PROBE_DUP == 6
            run_gemm(lds, hb, (const bf16_t*)(ws + WS_WUP + (size_t)layer * 8 * MiB), MTOK, DFF, DM, E);
#endif
            xcd_barrier(xbar);
            pg8::EpiResid E2{hb, ssq};
#if PROBE_DUP == 9
            { pg8::EpiResid E3{Y, (float*)(ws + WS_CS)}; run_gemm(lds, R1, (const bf16_t*)(ws + WS_WDN + (size_t)layer * 8 * MiB), MTOK, DM, DFF, E3); }
#endif
            run_gemm(lds, R1, (const bf16_t*)(ws + WS_WDN + (size_t)layer * 8 * MiB), MTOK, DM, DFF, E2);
        }
        xcd_barrier(xbar);
    }
#if PROBE_DUP == 10
    for (int i = 0; i < 10; ++i) xcd_barrier(xbar);
#endif
    final_phase(p);
#if PROBE_DUP == 11
    if (threadIdx.x == 0 && (hw_xcc_id() & 7u) != (blockIdx.x & 7u)) p.out[blockIdx.x] = __builtin_nanf("");
#endif
}

extern "C" void kernel_launch(void* const* d_in, const int* in_sizes, int n_in, void* d_out, int out_size, void* d_ws, size_t ws_size, hipStream_t stream) {
    static int grid = 0;
    if (grid == 0) {
        if (n_in != 26 || out_size != MTOK * DM || ws_size < WS_END) { fprintf(stderr, "kernel_launch: unexpected shapes (n_in %d out %d ws %zu)\n", n_in, out_size, ws_size); grid = -1; return; }
        int dev = 0, cus = 0, per_cu = 0;
        hipGetDevice(&dev);
        hipDeviceGetAttribute(&cus, hipDeviceAttributeMultiprocessorCount, dev);
        if (hipFuncSetAttribute((const void*)mega_fwd, hipFuncAttributeMaxDynamicSharedMemorySize, LDS_BYTES) != hipSuccess) { fprintf(stderr, "kernel_launch: hipFuncSetAttribute failed\n"); grid = -1; return; }
        if (hipOccupancyMaxActiveBlocksPerMultiprocessor(&per_cu, (const void*)mega_fwd, 512, LDS_BYTES) != hipSuccess || per_cu < 1) { fprintf(stderr, "kernel_launch: occupancy query says %d\n", per_cu); per_cu = 1; }
        (void)hipGetLastError();
        grid = cus * per_cu;
    }
    if (grid < 0) return;
    if (hipMemsetAsync((char*)d_ws + WS_BAR, 0, WS_BAR_BYTES, stream) != hipSuccess) { fprintf(stderr, "kernel_launch: memset failed\n"); return; }
    Params prm{};
    for (int i = 0; i < 26; ++i) prm.in[i] = (const float*)d_in[i];
    prm.out = (float*)d_out; prm.ws = (unsigned char*)d_ws;
    void* args[] = {&prm};
    hipError_t e = hipLaunchCooperativeKernel((const void*)mega_fwd, dim3(grid), dim3(512), args, LDS_BYTES, stream);
    if (e != hipSuccess) fprintf(stderr, "cooperative launch failed: %s (grid %d)\n", hipGetErrorString(e), grid);
}
```

```cpp
#include <hip/hip_runtime.h>
#include <hip/hip_cooperative_groups.h>
#include <cstdio>
#include <cstdint>
namespace cg = cooperative_groups;
#ifndef PROBE_DRY
#define PROBE_DRY 0
#endif
#ifndef PROBE_DUP
#define PROBE_DUP 0
#endif

#define LAS __attribute__((address_space(3)))
typedef unsigned short bf16_t;
typedef short bf16x8 __attribute__((ext_vector_type(8)));
typedef short s16x4 __attribute__((ext_vector_type(4)));
typedef float f32x4 __attribute__((ext_vector_type(4)));
typedef float f32x2 __attribute__((ext_vector_type(2)));
typedef unsigned u32x4 __attribute__((ext_vector_type(4)));
typedef unsigned u32x2 __attribute__((ext_vector_type(2)));

constexpr int DM = 1024, NB = 32, SEQ = 2048, MTOK = NB * SEQ, MEMLEN = 256, MMEM = NB * MEMLEN;
constexpr int ABN = 2560, AB_IN = 2568, CDN = 2304, DFF = 4096;
constexpr float EPS = 1e-6f;
constexpr float LOG2E = 1.4426950408889634f;

typedef __bf16 bf16x2_t __attribute__((ext_vector_type(2)));
__device__ __forceinline__ unsigned pk2(float lo, float hi) { f32x2 v = {lo, hi}; bf16x2_t b = __builtin_convertvector(v, bf16x2_t); return __builtin_bit_cast(unsigned, b); }
__device__ __forceinline__ unsigned f2bf(float f) { return pk2(f, 0.f) & 0xffffu; }
__device__ __forceinline__ float bf2f(unsigned b) { return __uint_as_float(b << 16); }
__device__ __forceinline__ float wave_sum(float v) {
#pragma unroll
    for (int o = 32; o >= 1; o >>= 1) v += __shfl_xor(v, o);
    return v;
}
__device__ __forceinline__ float ex2(float x) { return __builtin_amdgcn_exp2f(x); }
__device__ __forceinline__ float max2f(float x, float y) { return __builtin_amdgcn_fmed3f(x, y, INFINITY); }
__device__ __forceinline__ float max3f(float x, float y, float z) { return max2f(max2f(x, y), z); }
__device__ __forceinline__ float xor16_max(float x) { const auto rr = __builtin_amdgcn_permlane16_swap(__float_as_uint(x), __float_as_uint(x), false, false); return max2f(__uint_as_float(rr[0]), __uint_as_float(rr[1])); }
__device__ __forceinline__ float xor32_max(float x) { const auto rr = __builtin_amdgcn_permlane32_swap(__float_as_uint(x), __float_as_uint(x), false, false); return max2f(__uint_as_float(rr[0]), __uint_as_float(rr[1])); }
__device__ __forceinline__ float xor16_sum(float x) { const auto rr = __builtin_amdgcn_permlane16_swap(__float_as_uint(x), __float_as_uint(x), false, false); return __uint_as_float(rr[0]) + __uint_as_float(rr[1]); }
__device__ __forceinline__ float xor32_sum(float x) { const auto rr = __builtin_amdgcn_permlane32_swap(__float_as_uint(x), __float_as_uint(x), false, false); return __uint_as_float(rr[0]) + __uint_as_float(rr[1]); }
__device__ __forceinline__ float quad_max(float x) { return xor32_max(xor16_max(x)); }
__device__ __forceinline__ float quad_sum(float x) { return xor32_sum(xor16_sum(x)); }
namespace pg8 {
#define PG8_LAS __attribute__((address_space(3)))
typedef unsigned short bf16_t;
typedef short bf16x8 __attribute__((ext_vector_type(8)));
typedef float f32x4 __attribute__((ext_vector_type(4)));
typedef unsigned u32x4 __attribute__((ext_vector_type(4)));
constexpr int BM = 256, BK = 64, HALF = 128, HTB = HALF * BK * 2  , STAGE_BYTES = 8 * HTB, NXCD = 8, WGM = 8;

__host__ __device__ __forceinline__ int lds_byte(int r, int c) { const int st = (r >> 4) * 2 + (c >> 5), rr = r & 15, cc = c & 31, ob = rr * 64 + cc * 2; return st * 1024 + (ob ^ (((ob >> 9) & 1) << 5)); }
__host__ __device__ __forceinline__ void stage_rc(int b, int& R, int& C) { const int st = b / 1024, sb = b % 1024, swz = sb ^ (((sb >> 9) & 1) << 5); R = (st >> 1) * 16 + swz / 64; C = (st & 1) * 32 + (swz % 64) / 2; }
__host__ __device__ __forceinline__ int perm32(int rho) { const int n = rho >> 4, i = rho & 15; return 8 * (i >> 2) + 4 * n + (i & 3); }

struct Unit { int pm, pn; };
struct Gemm { const bf16_t* A; const bf16_t* Bt; int M, N, K; };

struct StaticOrder {
    int nM, nN, nwg, G, c;
    __host__ __device__ void init(int M, int N, int G_, int c_) { nM = M / BM; nN = N / BM; nwg = nM * nN; G = G_; c = c_; }
    __host__ __device__ bool next(int i, Unit& u) const {
        const long L = (long)i * G + c; if (L >= nwg) return false;
        int wgid = (int)L; { const int q = nwg / NXCD, r = nwg % NXCD, xcd = wgid % NXCD, off = wgid / NXCD; wgid = (xcd < r ? xcd * (q + 1) : r * (q + 1) + (xcd - r) * q) + off; }
        const int nig = WGM * nN, gid = wgid / nig, fm = gid * WGM, gsz = (nM - fm) < WGM ? (nM - fm) : WGM;
        u.pm = fm + ((wgid % nig) % gsz); u.pn = (wgid % nig) / gsz; return true;
    }
    __device__ __forceinline__ void a_ready(const Unit&) const {}
    __device__ __forceinline__ void done(const Unit&) const {}
};


__device__ __forceinline__ float row_rstd(const float* ssq, int row) {
    const f32x4* s = (const f32x4*)(ssq + (size_t)row * 16);
    const f32x4 a = s[0], b = s[1], c = s[2], d = s[3];
    const float t = ((a[0] + a[1]) + (a[2] + a[3])) + ((b[0] + b[1]) + (b[2] + b[3])) + ((c[0] + c[1]) + (c[2] + c[3])) + ((d[0] + d[1]) + (d[2] + d[3]));
    return 1.0f / sqrtf(t * (1.0f / 1024.0f) + EPS);
}
__device__ __forceinline__ void rstd8(const float* ssq, int row0, int fq, float (&rs)[8]) {
    f32x4 q[8];
#pragma unroll
    for (int i = 0; i < 8; ++i) q[i] = *(const f32x4*)(ssq + (size_t)(row0 + (i >> 2) * HALF + (i & 3) * 16) * 16 + 4 * fq);
    __builtin_amdgcn_sched_barrier(0);
#pragma unroll
    for (int i = 0; i < 8; ++i) { const float t = quad_sum((q[i][0] + q[i][1]) + (q[i][2] + q[i][3])); rs[i] = __builtin_amdgcn_rsqf(t * (1.0f / 1024.0f) + EPS); }
}
template <int ACT> struct EpiScale {
    static constexpr bool PERM = true, AFTER_DRAIN = false;
    bf16_t* O; int ldc; const float* ssq;
    __device__ __forceinline__ void operator()(const f32x4 (&acc)[2][2][4][2], const Unit& u, int wr, int wc, int fr, int fq) const {
        const int row0 = u.pm * BM + wr * 64 + fr, col0 = u.pn * BM + wc * 32 + 8 * fq;
        float rs[8];
        if (ssq) rstd8(ssq, row0, fq, rs);
        else {
#pragma unroll
            for (int i = 0; i < 8; ++i) rs[i] = 1.0f;
        }
#pragma unroll
        for (int ai = 0; ai < 2; ++ai)
#pragma unroll
            for (int m = 0; m < 4; ++m) {
                const int row = row0 + ai * HALF + m * 16;
                const float r1 = rs[ai * 4 + m];
                bf16_t* rowp = O + (size_t)row * ldc + col0;
#pragma unroll
                for (int bj = 0; bj < 2; ++bj) {
                    f32x4 v0 = acc[ai][bj][m][0] * r1, v1 = acc[ai][bj][m][1] * r1;
                    if (ACT == 1) {
#pragma unroll
                        for (int e = 0; e < 4; ++e) { float a = fmaxf(v0[e], 0.f), b = fmaxf(v1[e], 0.f); v0[e] = a * a; v1[e] = b * b; }
                    }
                    u32x4 w; w.x = pk2(v0[0], v0[1]); w.y = pk2(v0[2], v0[3]); w.z = pk2(v1[0], v1[1]); w.w = pk2(v1[2], v1[3]);
                    if (ACT == 1) __builtin_nontemporal_store(w, (u32x4*)(rowp + bj * HALF));
                    else *(u32x4*)(rowp + bj * HALF) = w;
                }
            }
    }
};
struct EpiResid {
    static constexpr bool PERM = true, AFTER_DRAIN = false;
    bf16_t* hb; float* ssq;
    __device__ __forceinline__ void operator()(const f32x4 (&acc)[2][2][4][2], const Unit& u, int wr, int wc, int fr, int fq) const {
        const int row0 = u.pm * BM + wr * 64 + fr, col0 = u.pn * BM + wc * 32 + 8 * fq;
        u32x4 bw[8][2];
#pragma unroll
        for (int i = 0; i < 8; ++i)
#pragma unroll
            for (int bj = 0; bj < 2; ++bj) bw[i][bj] = *(const u32x4*)(hb + (size_t)(row0 + (i >> 2) * HALF + (i & 3) * 16) * DM + col0 + bj * HALF);
        __builtin_amdgcn_sched_barrier(0);
#pragma unroll
        for (int ai = 0; ai < 2; ++ai)
#pragma unroll
            for (int m = 0; m < 4; ++m) {
                const int row = row0 + ai * HALF + m * 16;
                const size_t off = (size_t)row * DM + col0;
                float sq = 0.f;
#pragma unroll
                for (int bj = 0; bj < 2; ++bj) {
                    const u32x4 b4 = bw[ai * 4 + m][bj];
                    f32x4 v0 = acc[ai][bj][m][0], v1 = acc[ai][bj][m][1];
                    v0[0] += __uint_as_float(b4.x << 16); v0[1] += __uint_as_float(b4.x & 0xffff0000u); v0[2] += __uint_as_float(b4.y << 16); v0[3] += __uint_as_float(b4.y & 0xffff0000u);
                    v1[0] += __uint_as_float(b4.z << 16); v1[1] += __uint_as_float(b4.z & 0xffff0000u); v1[2] += __uint_as_float(b4.w << 16); v1[3] += __uint_as_float(b4.w & 0xffff0000u);
                    u32x4 w; w.x = pk2(v0[0], v0[1]); w.y = pk2(v0[2], v0[3]); w.z = pk2(v1[0], v1[1]); w.w = pk2(v1[2], v1[3]);
                    *(u32x4*)(hb + off + bj * HALF) = w;
                    sq += (v0[0] * v0[0] + v0[1] * v0[1]) + (v0[2] * v0[2] + v0[3] * v0[3]) + (v1[0] * v1[0] + v1[1] * v1[1]) + (v1[2] * v1[2] + v1[3] * v1[3]);
                }
                sq = quad_sum(sq);
                if (fq == 0) ssq[(size_t)row * 16 + u.pn * 4 + wc] = sq;
            }
    }
};
struct EpiRope {
    static constexpr bool PERM = false, AFTER_DRAIN = false;
    bf16_t* O; const float* ssq; const f32x2* tab;
    __device__ __forceinline__ void operator()(const f32x4 (&acc)[2][2][4][2], const Unit& u, int wr, int wc, int fr, int fq) const {
        const int row0 = u.pm * BM + wr * 64 + fr;
        const int hh = wc & 1;
        float rs[8];
        rstd8(ssq, row0, fq, rs);
#pragma unroll
        for (int ai = 0; ai < 2; ++ai) {
            f32x4 tb[4][2];
#pragma unroll
            for (int i = 0; i < 4; ++i) {
                const int pos = (row0 + ai * HALF + i * 16) & (SEQ - 1);
                const f32x4* t4 = (const f32x4*)(tab + (size_t)pos * 32 + 16 * hh + 4 * fq);
                tb[i][0] = t4[0]; tb[i][1] = t4[1];
            }
            __builtin_amdgcn_sched_barrier(0);
#pragma unroll
            for (int m = 0; m < 4; ++m) {
                const int row = row0 + ai * HALF + m * 16;
                const float r1 = rs[ai * 4 + m];
                const size_t hrow = (size_t)(row >> 11) * 36 * SEQ + (row & (SEQ - 1));
#pragma unroll
                for (int bj = 0; bj < 2; ++bj) {
                    const int gcol = u.pn * BM + bj * HALF + wc * 32;
                    const bool rope = (gcol < 1024) || (gcol >= 1536 && gcol < 2176);
                    f32x4 a = acc[ai][bj][m][0] * r1, b = acc[ai][bj][m][1] * r1;
                    int ca, cb;
                    if (rope) {
                        const f32x4 t0 = tb[m][0], t1 = tb[m][1];
                        f32x4 x1, x2;
                        x1[0] = a[0] * t0[0] - b[0] * t0[1]; x2[0] = b[0] * t0[0] + a[0] * t0[1];
                        x1[1] = a[1] * t0[2] - b[1] * t0[3]; x2[1] = b[1] * t0[2] + a[1] * t0[3];
                        x1[2] = a[2] * t1[0] - b[2] * t1[1]; x2[2] = b[2] * t1[0] + a[2] * t1[1];
                        x1[3] = a[3] * t1[2] - b[3] * t1[3]; x2[3] = b[3] * t1[2] + a[3] * t1[3];
                        a = x1; b = x2;
                        ca = (gcol & ~63) + 16 * hh + 4 * fq; cb = ca + 32;
                    } else { ca = gcol + 4 * fq; cb = ca + 16; }
                    u32x2 wa, wb; wa.x = pk2(a[0], a[1]); wa.y = pk2(a[2], a[3]); wb.x = pk2(b[0], b[1]); wb.y = pk2(b[2], b[3]);
                    bf16_t* hp = O + (hrow + (size_t)(ca >> 6) * SEQ) * 64;
                    *(u32x2*)(hp + (ca & 63)) = wa; *(u32x2*)(hp + (cb & 63)) = wb;
                }
            }
        }
    }
};

template <class Epi, class Sched, bool ALIGN_EPI = false, bool SP2 = false>
__device__ __forceinline__ void gemm_phase(PG8_LAS unsigned char* lds, const Gemm g, const Sched& S, const Epi& E) {
    int tid_l = threadIdx.x; asm volatile("" : "+v"(tid_l)); const int tid = tid_l, wid = __builtin_amdgcn_readfirstlane(tid >> 6), lane = tid & 63, wr = wid >> 2, wc = wid & 3, fr = lane & 15, fq = lane >> 4;
    const int K = g.K, nt = K / BK;
    unsigned voffA[2], voffB[2];
#pragma unroll
    for (int i = 0; i < 2; ++i) { int R, C; stage_rc(tid * 16 + i * 8192, R, C); const int Rb = Epi::PERM ? ((R & ~31) + perm32(R & 31)) : R;
        voffA[i] = (unsigned)(R * K + C) * 2u; voffB[i] = (unsigned)(Rb * K + C) * 2u; }
    const size_t kstep = (size_t)(BK * 2);
    const size_t hstep = (size_t)HALF * K * 2;
    const size_t tstep = 2 * hstep;
    const unsigned ldsw = (unsigned)wid * 1024u;
    const int aoff = lds_byte(wr * 64 + fr, fq * 8), boff = lds_byte(wc * 32 + fr, fq * 8);
#define PG8_SA(b, h) (((b) * 2 + (h)) * HTB)
#define PG8_SB(b, h) ((4 + (b) * 2 + (h)) * HTB)
#define PG8_STAGE(bufoff, gbase, voff) do { _Pragma("unroll") for (int _i = 0; _i < 2; ++_i) \
        __builtin_amdgcn_global_load_lds((const unsigned*)((const char*)(gbase) + (voff)[_i]), (PG8_LAS unsigned*)(lds + (bufoff) + ldsw + _i * 8192), 16, 0, 0); } while (0)
#define PG8_LDA(dst, b, h) do { _Pragma("unroll") for (int m = 0; m < 4; ++m) _Pragma("unroll") for (int k = 0; k < 2; ++k) dst[m][k] = *(const PG8_LAS bf16x8*)(lds + PG8_SA(b, h) + aoff + m * 2048 + k * 1024); } while (0)
#define PG8_LDB(dst, b, h) do { _Pragma("unroll") for (int n = 0; n < 2; ++n) _Pragma("unroll") for (int k = 0; k < 2; ++k) dst[n][k] = *(const PG8_LAS bf16x8*)(lds + PG8_SB(b, h) + boff + n * 2048 + k * 1024); } while (0)
#define PG8_MMA(ai, bj, At, Bt) do { __builtin_amdgcn_s_setprio(1); _Pragma("unroll") for (int m = 0; m < 4; ++m) _Pragma("unroll") for (int n = 0; n < 2; ++n) _Pragma("unroll") for (int k = 0; k < 2; ++k) \
        acc[ai][bj][m][n] = __builtin_amdgcn_mfma_f32_16x16x32_bf16(Bt[n][k], At[m][k], acc[ai][bj][m][n], 0, 0, 0); __builtin_amdgcn_s_setprio(0); } while (0)
#define PG8_WAIT_V(n) asm volatile("s_waitcnt vmcnt(" #n ")" ::: "memory")
#define PG8_WAIT_L(n) asm volatile("s_waitcnt lgkmcnt(" #n ")" ::: "memory")
#define PG8_BAR __builtin_amdgcn_s_barrier()
#define PG8_SCHED __builtin_amdgcn_sched_barrier(0)
    Unit cur, nxt; int ui = 0;
    if (!S.next(0, cur)) return;
    f32x4 acc[2][2][4][2];
#pragma unroll
    for (int a = 0; a < 2; ++a)
#pragma unroll
        for (int b = 0; b < 2; ++b)
#pragma unroll
            for (int m = 0; m < 4; ++m)
#pragma unroll
                for (int n = 0; n < 2; ++n) acc[a][b][m][n] = (f32x4){0.f, 0.f, 0.f, 0.f};
    bf16x8 At[4][2], B0[2][2], B1[2][2];
    const char* cA = (const char*)g.A + (size_t)cur.pm * tstep; const char* cB = (const char*)g.Bt + (size_t)cur.pn * tstep;
    S.a_ready(cur);
    if constexpr (SP2) {
        PG8_STAGE(PG8_SB(0, 0), cB, voffB); PG8_STAGE(PG8_SB(0, 1), cB + hstep, voffB); PG8_STAGE(PG8_SA(0, 0), cA, voffA); PG8_STAGE(PG8_SA(0, 1), cA + hstep, voffA);
        if (wr == 1) PG8_BAR;
        PG8_WAIT_V(2); PG8_BAR;
        PG8_STAGE(PG8_SB(1, 0), cB + kstep, voffB); PG8_STAGE(PG8_SA(1, 0), cA + kstep, voffA); PG8_STAGE(PG8_SB(1, 1), cB + hstep + kstep, voffB);
        PG8_WAIT_V(6); PG8_BAR;
    } else {
        PG8_STAGE(PG8_SB(0, 0), cB, voffB); PG8_STAGE(PG8_SA(0, 0), cA, voffA); PG8_STAGE(PG8_SB(0, 1), cB + hstep, voffB); PG8_STAGE(PG8_SA(0, 1), cA + hstep, voffA);
        if (wr == 1) PG8_BAR;
        PG8_WAIT_V(4); PG8_BAR;
        PG8_STAGE(PG8_SB(1, 0), cB + kstep, voffB); PG8_STAGE(PG8_SA(1, 0), cA + kstep, voffA); PG8_STAGE(PG8_SB(1, 1), cB + hstep + kstep, voffB);
        PG8_WAIT_V(6); PG8_BAR;
    }
    for (;;) {
        const bool has_next = S.next(ui + 1, nxt);
        const char* nA = has_next ? (const char*)g.A + (size_t)nxt.pm * tstep : cA; const char* nB = has_next ? (const char*)g.Bt + (size_t)nxt.pn * tstep : cB;
        for (int t = 0; t < nt; t += 2) {
            const bool last = (t == nt - 2);
            const char* a1 = cA + (size_t)(t + 1) * kstep;
            const char* a2 = last ? nA : cA + (size_t)(t + 2) * kstep; const char* b2 = last ? nB : cB + (size_t)(t + 2) * kstep;
            const char* a3 = a2 + kstep; const char* b3 = b2 + kstep;
            if (last && has_next) S.a_ready(nxt);
            if constexpr (SP2) {
            PG8_LDB(B0, 0, 0); PG8_LDB(B1, 0, 1); PG8_SCHED; PG8_LDA(At, 0, 0); PG8_STAGE(PG8_SA(1, 1), a1 + hstep, voffA);
            PG8_WAIT_V(8); PG8_WAIT_L(0); PG8_BAR; PG8_MMA(0, 0, At, B0); PG8_MMA(0, 1, At, B1); PG8_BAR; PG8_SCHED;
            PG8_LDA(At, 0, 1); PG8_STAGE(PG8_SB(0, 0), b2, voffB); PG8_STAGE(PG8_SB(0, 1), b2 + hstep, voffB); PG8_STAGE(PG8_SA(0, 0), a2, voffA);
            PG8_WAIT_V(8); PG8_WAIT_L(0); PG8_BAR; PG8_MMA(1, 0, At, B0); PG8_MMA(1, 1, At, B1); PG8_BAR; PG8_SCHED;
            PG8_LDB(B0, 1, 0); PG8_LDB(B1, 1, 1); PG8_SCHED; PG8_LDA(At, 1, 0); PG8_STAGE(PG8_SA(0, 1), a2 + hstep, voffA);
            PG8_WAIT_V(8); PG8_WAIT_L(0); PG8_BAR; PG8_MMA(0, 0, At, B0); PG8_MMA(0, 1, At, B1); PG8_BAR; PG8_SCHED;
            PG8_LDA(At, 1, 1); PG8_STAGE(PG8_SB(1, 0), b3, voffB); PG8_STAGE(PG8_SB(1, 1), b3 + hstep, voffB); PG8_STAGE(PG8_SA(1, 0), a3, voffA);
            PG8_WAIT_V(8); PG8_WAIT_L(0); PG8_BAR; PG8_MMA(1, 0, At, B0); PG8_MMA(1, 1, At, B1); PG8_BAR; PG8_SCHED;
            } else {
            PG8_LDB(B0, 0, 0); PG8_SCHED; PG8_LDA(At, 0, 0); PG8_STAGE(PG8_SA(1, 1), a1 + hstep, voffA);
            PG8_WAIT_L(8); PG8_BAR; PG8_WAIT_L(0); PG8_MMA(0, 0, At, B0); PG8_BAR; PG8_SCHED;
            PG8_LDB(B1, 0, 1); PG8_STAGE(PG8_SB(0, 0), b2, voffB);
            PG8_BAR; PG8_WAIT_L(0); PG8_MMA(0, 1, At, B1); PG8_BAR;
            PG8_LDA(At, 0, 1); PG8_STAGE(PG8_SA(0, 0), a2, voffA);
            PG8_BAR; PG8_WAIT_L(0); PG8_MMA(1, 0, At, B0); PG8_BAR; PG8_SCHED;
            PG8_STAGE(PG8_SB(0, 1), b2 + hstep, voffB);
            PG8_WAIT_V(6); PG8_BAR; PG8_MMA(1, 1, At, B1); PG8_BAR;
            PG8_LDB(B0, 1, 0); PG8_SCHED; PG8_LDA(At, 1, 0); PG8_STAGE(PG8_SA(0, 1), a2 + hstep, voffA);
            PG8_WAIT_L(8); PG8_BAR; PG8_WAIT_L(0); PG8_MMA(0, 0, At, B0); PG8_BAR; PG8_SCHED;
            PG8_LDB(B1, 1, 1); PG8_STAGE(PG8_SB(1, 0), b3, voffB);
            PG8_BAR; PG8_WAIT_L(0); PG8_MMA(0, 1, At, B1); PG8_BAR;
            PG8_LDA(At, 1, 1); PG8_STAGE(PG8_SA(1, 0), a3, voffA);
            PG8_BAR; PG8_WAIT_L(0); PG8_MMA(1, 0, At, B0); PG8_BAR; PG8_SCHED;
            PG8_STAGE(PG8_SB(1, 1), b3 + hstep, voffB);
            PG8_WAIT_V(6); PG8_BAR; PG8_MMA(1, 1, At, B1); PG8_BAR;
            }
        }
        if constexpr (ALIGN_EPI) { if (wr == 0) PG8_BAR; }
        if constexpr (!Epi::AFTER_DRAIN) { E(acc, cur, wr, wc, fr, fq); S.done(cur); }
        if (!has_next) break;
#pragma unroll
        for (int a = 0; a < 2; ++a)
#pragma unroll
            for (int b = 0; b < 2; ++b)
#pragma unroll
                for (int m = 0; m < 4; ++m)
#pragma unroll
                    for (int n = 0; n < 2; ++n) acc[a][b][m][n] = (f32x4){0.f, 0.f, 0.f, 0.f};
        cur = nxt; cA = nA; cB = nB; ++ui;
        if constexpr (ALIGN_EPI) { if (wr == 1) PG8_BAR; }
    }
    PG8_WAIT_V(0);
    if constexpr (!ALIGN_EPI) { if (wr == 0) PG8_BAR; }
    PG8_BAR;
    if constexpr (Epi::AFTER_DRAIN) { E.fused(acc, cur, wr, wc, fr, fq, lds, wid, lane); S.done(cur); }
#undef PG8_SA
#undef PG8_SB
#undef PG8_STAGE
#undef PG8_LDA
#undef PG8_LDB
#undef PG8_MMA
#undef PG8_WAIT_V
#undef PG8_WAIT_L
#undef PG8_BAR
#undef PG8_SCHED
}
}

constexpr size_t MiB = 1024 * 1024;
constexpr size_t WS_WIN0 = 0;
constexpr size_t WS_WOUT0 = WS_WIN0 + (size_t)ABN * DM * 2;
constexpr size_t WS_WIN1 = WS_WOUT0 + 2 * MiB;
constexpr size_t WS_WOUT1 = WS_WIN1 + (size_t)CDN * DM * 2;
constexpr size_t WS_WQ = WS_WOUT1 + 2 * MiB;
constexpr size_t WS_WKV = WS_WQ + 4 * MiB;
constexpr size_t WS_WO = WS_WKV + 8 * MiB;
constexpr size_t WS_WUP = WS_WO + 4 * MiB;
constexpr size_t WS_WDN = WS_WUP + 16 * MiB;
constexpr size_t WS_HB = WS_WDN + 16 * MiB;
constexpr size_t WS_SSQ = WS_HB + 128 * MiB;
constexpr size_t WS_R1 = WS_SSQ + 4 * MiB;
constexpr size_t WS_Y = WS_R1 + 512 * MiB;
constexpr size_t WS_KV = WS_Y + 128 * MiB;
constexpr size_t WS_MEMN = WS_KV + 64 * MiB;
constexpr size_t WS_CS = WS_MEMN + 32 * MiB;
constexpr size_t WS_FL = WS_CS + 2 * MiB;
constexpr size_t WS_ROPE = WS_FL + 2 * MiB;
constexpr size_t WS_BAR = WS_ROPE + MiB / 2;
constexpr size_t WS_BAR_BYTES = 32768;
constexpr size_t WS_END = WS_BAR + WS_BAR_BYTES;
static_assert(WS_END <= 1024 * MiB, "workspace");
static_assert(WS_WOUT1 % 256 == 0 && WS_HB % 256 == 0, "align");

constexpr int LDS_BYTES = 155648;

struct Params { const float* in[26]; float* out; unsigned char* ws; };
__device__ __forceinline__ unsigned hw_xcc_id() { return (unsigned)__builtin_amdgcn_s_getreg((3 << 11) | 20) & 0xFu; }

__device__ __forceinline__ int colmap1(int n) {
    const bool rope = (n < 1024) || (n >= 1536 && n < 2176);
    if (!rope) return n;
    const int p = n & 63, hh = p >> 5, pp = p & 31;
    const int orig = (pp < 16) ? (16 * hh + pp) : (32 + 16 * hh + pp - 16);
    return (n & ~63) + orig;
}
__device__ __forceinline__ void conv_weight(LAS float* tile, const float* __restrict__ src, bf16_t* __restrict__ dst, const float* __restrict__ gain, int K, int N, int ldsrc, int mode,
                                            float qs, int qlo, int qhi, int q2lo, int q2hi, int& base) {
    const int G = gridDim.x, tid = threadIdx.x;
    const int nkt = K >> 6, ntiles = nkt * (N >> 6);
    int start = ((int)blockIdx.x - base) % G; if (start < 0) start += G;
    for (int t = start; t < ntiles; t += G) {
        const int k0 = (t % nkt) << 6, n0 = (t / nkt) << 6;
        {
            const int c = tid & 63, r0 = tid >> 6, n = n0 + c;
            const int sc = mode ? colmap1(n) : n;
            const float cs = ((n >= qlo && n < qhi) || (n >= q2lo && n < q2hi)) ? qs : 1.0f;
#pragma unroll
            for (int i = 0; i < 8; ++i) {
                const int r = r0 + 8 * i, k = k0 + r;
                float v = src[(size_t)k * ldsrc + sc] * cs;
                if (gain) v *= gain[k];
                tile[r * 65 + c] = v;
            }
        }
        __syncthreads();
        {
            const int rr = tid >> 3, ch = tid & 7;
            float v[8];
#pragma unroll
            for (int j = 0; j < 8; ++j) v[j] = tile[(ch * 8 + j) * 65 + rr];
            u32x4 w; w.x = pk2(v[0], v[1]); w.y = pk2(v[2], v[3]); w.z = pk2(v[4], v[5]); w.w = pk2(v[6], v[7]);
            *(u32x4*)(dst + (size_t)(n0 + rr) * K + k0 + ch * 8) = w;
        }
        __syncthreads();
    }
    base = (base + ntiles) % G;
}

__device__ __forceinline__ void p0_prologue(const Params& p, LAS unsigned char* lds) {
    unsigned char* ws = p.ws;
    int tid_l = threadIdx.x; asm volatile("" : "+v"(tid_l)); const int tid = tid_l, lane = tid & 63, wid = tid >> 6, G = gridDim.x;
    LAS float* tile = (LAS float*)lds;
    int base = 0;
    const float QS64 = 0.125f * LOG2E, QS256 = 0.0625f * LOG2E;
    conv_weight(tile, p.in[3], (bf16_t*)(ws + WS_WIN0), p.in[2], DM, ABN, AB_IN, 0, QS64, 1024, 1536, 0, 0, base);
    conv_weight(tile, p.in[12], (bf16_t*)(ws + WS_WOUT0), nullptr, DM, DM, DM, 0, 1.f, 0, 0, 0, 0, base);
    conv_weight(tile, p.in[14], (bf16_t*)(ws + WS_WIN1), p.in[13], DM, CDN, CDN, 1, QS64, 0, 512, 1536, 2048, base);
    conv_weight(tile, p.in[16], (bf16_t*)(ws + WS_WOUT1), nullptr, DM, DM, DM, 0, 1.f, 0, 0, 0, 0, base);
    for (int l = 0; l < 2; ++l) {
        conv_weight(tile, p.in[19] + (size_t)l * DM * DM, (bf16_t*)(ws + WS_WQ + l * 2 * MiB), p.in[17] + l * DM, DM, DM, DM, 0, QS256, 0, DM, 0, 0, base);
        conv_weight(tile, p.in[20] + (size_t)l * DM * 2 * DM, (bf16_t*)(ws + WS_WKV + l * 4 * MiB), nullptr, DM, 2 * DM, 2 * DM, 0, 1.f, 0, 0, 0, 0, base);
        conv_weight(tile, p.in[21] + (size_t)l * DM * DM, (bf16_t*)(ws + WS_WO + l * 2 * MiB), nullptr, DM, DM, DM, 0, 1.f, 0, 0, 0, 0, base);
        conv_weight(tile, p.in[23] + (size_t)l * DM * DFF, (bf16_t*)(ws + WS_WUP + l * 8 * MiB), p.in[22] + l * DM, DM, DFF, DFF, 0, 1.f, 0, 0, 0, 0, base);
        conv_weight(tile, p.in[24] + (size_t)l * DFF * DM, (bf16_t*)(ws + WS_WDN + l * 8 * MiB), nullptr, DFF, DM, DM, 0, 1.f, 0, 0, 0, 0, base);
    }
    __syncthreads();
    LAS float* wf = (LAS float*)lds;
    for (int i = tid; i < 8 * DM; i += 512) { const int j = i >> 10, k = i & 1023; wf[i] = p.in[3][(size_t)k * AB_IN + ABN + j] * p.in[2][k]; }
    __syncthreads();
    const int gw = blockIdx.x * 8 + wid, NGW = G * 8;
    bf16_t* hb = (bf16_t*)(ws + WS_HB);
    float* ssq = (float*)(ws + WS_SSQ);
    float* fl = (float*)(ws + WS_FL);
    f32x4 vn[4];
    if (gw < MTOK) {
        const f32x4* xr0 = (const f32x4*)(p.in[0] + (size_t)gw * DM);
#pragma unroll
        for (int i = 0; i < 4; ++i) vn[i] = __builtin_nontemporal_load(xr0 + lane + 64 * i);
    }
    for (int row = gw; row < MTOK; row += NGW) {
        f32x4 v[4];
#pragma unroll
        for (int i = 0; i < 4; ++i) v[i] = vn[i];
        if (row + NGW < MTOK) {
            const f32x4* xr = (const f32x4*)(p.in[0] + (size_t)(row + NGW) * DM);
#pragma unroll
            for (int i = 0; i < 4; ++i) vn[i] = __builtin_nontemporal_load(xr + lane + 64 * i);
        }
        float s = 0.f, a[8];
#pragma unroll
        for (int j = 0; j < 8; ++j) a[j] = 0.f;
#pragma unroll
        for (int i = 0; i < 4; ++i) {
            s += (v[i][0] * v[i][0] + v[i][1] * v[i][1]) + (v[i][2] * v[i][2] + v[i][3] * v[i][3]);
#pragma unroll
            for (int j = 0; j < 8; ++j) { const f32x4 w = *(const LAS f32x4*)(wf + j * DM + 4 * (lane + 64 * i)); a[j] += (v[i][0] * w[0] + v[i][1] * w[1]) + (v[i][2] * w[2] + v[i][3] * w[3]); }
            u32x2 w2; w2.x = pk2(v[i][0], v[i][1]); w2.y = pk2(v[i][2], v[i][3]);
            *(u32x2*)(hb + (size_t)row * DM + 4 * (lane + 64 * i)) = w2;
        }
        s = wave_sum(s);
        const float rs = 1.0f / sqrtf(s * (1.0f / 1024.0f) + EPS);
        float mine = 0.f;
#pragma unroll
        for (int j = 0; j < 8; ++j) { const float t = wave_sum(a[j]) * rs; if (lane == j) mine = t; }
        if (lane < 8) fl[(size_t)row * 8 + lane] = mine;
        if (lane < 16) ssq[(size_t)row * 16 + lane] = (lane == 0) ? s : 0.f;
    }
    for (int row = gw; row < MMEM; row += NGW) {
        const f32x4* xr = (const f32x4*)(p.in[1] + (size_t)row * DM);
        f32x4 v[4];
        float s = 0.f;
#pragma unroll
        for (int i = 0; i < 4; ++i) { v[i] = xr[lane + 64 * i]; s += (v[i][0] * v[i][0] + v[i][1] * v[i][1]) + (v[i][2] * v[i][2] + v[i][3] * v[i][3]); }
        s = wave_sum(s);
        const float rs = 1.0f / sqrtf(s * (1.0f / 1024.0f) + EPS);
#pragma unroll
        for (int l = 0; l < 2; ++l) {
            bf16_t* dst = (bf16_t*)(ws + WS_MEMN + l * 16 * MiB) + (size_t)row * DM;
#pragma unroll
            for (int i = 0; i < 4; ++i) {
                const f32x4 g = *(const f32x4*)(p.in[18] + l * DM + 4 * (lane + 64 * i));
                u32x2 w2; w2.x = pk2(v[i][0] * rs * g[0], v[i][1] * rs * g[1]); w2.y = pk2(v[i][2] * rs * g[2], v[i][3] * rs * g[3]);
                *(u32x2*)(dst + 4 * (lane + 64 * i)) = w2;
            }
        }
    }
    f32x2* tab = (f32x2*)(ws + WS_ROPE);
    for (int idx = blockIdx.x * 512 + tid; idx < SEQ * 32; idx += G * 512) {
        const int pos = idx >> 5, i = idx & 31;
        const float inv = exp2f(-(float)i * (13.287712379549449f / 32.0f));
        const float ang = (float)pos * inv;
        f32x2 cs; cs[0] = cosf(ang); cs[1] = sinf(ang);
        tab[idx] = cs;
    }
    __syncthreads();
}

__device__ __forceinline__ void fox_cumsum(const Params& p) {
    int tid_l = threadIdx.x; asm volatile("" : "+v"(tid_l)); const int tid = tid_l, lane = tid & 63, wid = tid >> 6;
    if (wid != 0) return;
    const float* fl = (const float*)(p.ws + WS_FL);
    float* cs2 = (float*)(p.ws + WS_CS);
    for (int seq = blockIdx.x; seq < NB * 8; seq += gridDim.x) {
        const int b = seq >> 3, h = seq & 7;
        const float bf = p.in[11][h];
        const float* src = fl + ((size_t)b * SEQ + lane * 32) * 8 + h;
        float tot = 0.f;
        for (int i = 0; i < 32; ++i) { const float y = src[i * 8] + bf; tot += fminf(y, 0.f) - log1pf(expf(-fabsf(y))); }
        float incl = tot;
#pragma unroll
        for (int o = 1; o < 64; o <<= 1) { const float t = __shfl_up(incl, o); if (lane >= o) incl += t; }
        float run = incl - tot;
        float* dst = cs2 + (size_t)seq * SEQ + lane * 32;
        for (int i = 0; i < 32; ++i) { const float y = src[i * 8] + bf; run += fminf(y, 0.f) - log1pf(expf(-fabsf(y))); dst[i] = run * LOG2E; }
    }
}

__device__ __forceinline__ s16x4 vtr(LAS const unsigned char* p) { return __builtin_bit_cast(s16x4, __builtin_amdgcn_ds_read_tr16_b64_v4i16((LAS s16x4*)p)); }

template <int NKT, int QT, int DT, int KSTR, int VSTR, class F>
__device__ __forceinline__ void attn_stage(f32x4 (&O)[QT][DT], float (&mrow)[QT], float (&lsum)[QT], const bf16x8 (&Qf)[QT][DT / 2],
                                           LAS const unsigned char* Ks, LAS const unsigned char* Vs, const F& fn, int lane) {
    const int li = lane & 15, g = lane >> 4;
    constexpr int KS = DT / 2;
    constexpr int KTB = (KS >= 8) ? 1 : 2;
    constexpr int NKB = NKT / KTB;
    static_assert(NKT % KTB == 0 && NKT % 2 == 0, "attn_stage shape");
    f32x4 S[QT][NKT];
    if constexpr (KS >= 8) {
        constexpr int HB = KS / 4, NB = NKT * HB;
        bf16x8 kf[2][4];
        LAS const unsigned char* kbase = Ks + li * KSTR + 16 * g;
#pragma unroll
        for (int j = 0; j < 4; ++j) kf[0][j] = *(LAS const bf16x8*)(kbase + 64 * j);
#pragma unroll
        for (int bi = 0; bi < NB; ++bi) {
            if (bi + 1 < NB) {
                const int kt1 = (bi + 1) / HB, k1 = ((bi + 1) % HB) * 4;
#pragma unroll
                for (int j = 0; j < 4; ++j) kf[(bi + 1) & 1][j] = *(LAS const bf16x8*)(kbase + (16 * kt1) * KSTR + 64 * (k1 + j));
            }
            __builtin_amdgcn_sched_barrier(0); __builtin_amdgcn_s_setprio(1);
            const int kt = bi / HB, k0 = (bi % HB) * 4;
            if (k0 == 0) {
                const f32x4 s0 = fn.init(kt);
#pragma unroll
                for (int qt = 0; qt < QT; ++qt) S[qt][kt] = s0;
            }
#pragma unroll
            for (int j = 0; j < 4; ++j)
#pragma unroll
                for (int qt = 0; qt < QT; ++qt) S[qt][kt] = __builtin_amdgcn_mfma_f32_16x16x32_bf16(kf[bi & 1][j], Qf[qt][k0 + j], S[qt][kt], 0, 0, 0);
__builtin_amdgcn_s_setprio(0); __builtin_amdgcn_sched_barrier(0);
        }
    } else {
        bf16x8 kf[2][KTB][KS];
        LAS const unsigned char* kbase = Ks + li * KSTR + 16 * g;
#pragma unroll
        for (int t = 0; t < KTB; ++t)
#pragma unroll
            for (int ks = 0; ks < KS; ++ks) kf[0][t][ks] = *(LAS const bf16x8*)(kbase + (16 * t) * KSTR + 64 * ks);
#pragma unroll
        for (int kb = 0; kb < NKB; ++kb) {
            if (kb + 1 < NKB) {
#pragma unroll
                for (int t = 0; t < KTB; ++t)
#pragma unroll
                    for (int ks = 0; ks < KS; ++ks) kf[(kb + 1) & 1][t][ks] = *(LAS const bf16x8*)(kbase + (16 * ((kb + 1) * KTB + t)) * KSTR + 64 * ks);
            }
            __builtin_amdgcn_sched_barrier(0); __builtin_amdgcn_s_setprio(1);
#pragma unroll
            for (int t = 0; t < KTB; ++t) {
                const int kt = kb * KTB + t;
                const f32x4 s0 = fn.init(kt);
#pragma unroll
                for (int qt = 0; qt < QT; ++qt) S[qt][kt] = s0;
#pragma unroll
                for (int ks = 0; ks < KS; ++ks)
#pragma unroll
                    for (int qt = 0; qt < QT; ++qt) S[qt][kt] = __builtin_amdgcn_mfma_f32_16x16x32_bf16(kf[kb & 1][t][ks], Qf[qt][ks], S[qt][kt], 0, 0, 0);
            }
__builtin_amdgcn_s_setprio(0); __builtin_amdgcn_sched_barrier(0);
        }
    }
#pragma unroll
    for (int qt = 0; qt < QT; ++qt) {
        float mx = -INFINITY;
#pragma unroll
        for (int kt = 0; kt < NKT; ++kt) { S[qt][kt] = fn.apply(S[qt][kt], qt, kt); mx = max3f(mx, S[qt][kt][0], S[qt][kt][1]); mx = max3f(mx, S[qt][kt][2], S[qt][kt][3]); }
        mx = quad_max(mx);
        const float mnew = max2f(mrow[qt], mx);
        const float msub = (mnew == -INFINITY) ? 0.f : mnew;
        const float alpha = ex2(mrow[qt] - msub);
        mrow[qt] = mnew;
        float ps = 0.f;
#pragma unroll
        for (int kt = 0; kt < NKT; ++kt)
#pragma unroll
            for (int e = 0; e < 4; ++e) { const float pv = ex2(S[qt][kt][e] - msub); S[qt][kt][e] = pv; ps += pv; }
        lsum[qt] = lsum[qt] * alpha + ps;
#pragma unroll
        for (int dt = 0; dt < DT; ++dt) O[qt][dt] = O[qt][dt] * alpha;
    }
    {
        constexpr int NS = NKT / 2;
        constexpr int DTB = (DT > 4) ? 4 : DT;
        constexpr int NDB = DT / DTB, NVB = NS * NDB;
        bf16x8 Pf[QT][NS];
#pragma unroll
        for (int s = 0; s < NS; ++s)
#pragma unroll
            for (int qt = 0; qt < QT; ++qt) {
                u32x4 w; w.x = pk2(S[qt][2 * s][0], S[qt][2 * s][1]); w.y = pk2(S[qt][2 * s][2], S[qt][2 * s][3]);
                w.z = pk2(S[qt][2 * s + 1][0], S[qt][2 * s + 1][1]); w.w = pk2(S[qt][2 * s + 1][2], S[qt][2 * s + 1][3]);
                Pf[qt][s] = __builtin_bit_cast(bf16x8, w);
            }
        const int q = li >> 2, pp = li & 3;
        LAS const unsigned char* vbase = Vs + (4 * g + q) * VSTR + 8 * pp;
        s16x4 va[2][DTB][2];
#pragma unroll
        for (int j = 0; j < DTB; ++j) { va[0][j][0] = vtr(vbase + 32 * j); va[0][j][1] = vtr(vbase + 16 * VSTR + 32 * j); }
#pragma unroll
        for (int bi = 0; bi < NVB; ++bi) {
            if (bi + 1 < NVB) {
                const int s1 = (bi + 1) / NDB, d1 = ((bi + 1) % NDB) * DTB;
#pragma unroll
                for (int j = 0; j < DTB; ++j) { va[(bi + 1) & 1][j][0] = vtr(vbase + (32 * s1) * VSTR + 32 * (d1 + j)); va[(bi + 1) & 1][j][1] = vtr(vbase + (32 * s1 + 16) * VSTR + 32 * (d1 + j)); }
            }
            __builtin_amdgcn_sched_barrier(0); __builtin_amdgcn_s_setprio(1);
            const int s = bi / NDB, d0 = (bi % NDB) * DTB;
#pragma unroll
            for (int j = 0; j < DTB; ++j) {
                const s16x4 a1 = va[bi & 1][j][0], a2 = va[bi & 1][j][1];
                const bf16x8 vf = (bf16x8){a1[0], a1[1], a1[2], a1[3], a2[0], a2[1], a2[2], a2[3]};
#pragma unroll
                for (int qt = 0; qt < QT; ++qt) O[qt][d0 + j] = __builtin_amdgcn_mfma_f32_16x16x32_bf16(vf, Pf[qt][s], O[qt][d0 + j], 0, 0, 0);
            }
__builtin_amdgcn_s_setprio(0); __builtin_amdgcn_sched_barrier(0);
        }
    }
}

__device__ __forceinline__ float rcp_(float x) { return __builtin_amdgcn_rcpf(x); }
__device__ __forceinline__ float sigmoidf_(float x) { return rcp_(1.0f + ex2(-LOG2E * x)); }
__device__ __forceinline__ float gelu_tanh(float x) { const float y = 0.7978845608028654f * (x + 0.044715f * x * x * x); const float t = 1.0f - 2.0f * rcp_(1.0f + ex2((2.0f * LOG2E) * y)); return 0.5f * x * (1.0f + t); }
__device__ __forceinline__ float one_minus_exp(float x) {
    const float p = -x * (1.0f + x * (0.5f + x * ((1.0f / 6.0f) + x * ((1.0f / 24.0f) + x * ((1.0f / 120.0f) + x * (1.0f / 720.0f))))));
    const float d = 1.0f - ex2(LOG2E * x);
    return (x < -0.3f) ? d : p;
}

__device__ __forceinline__ void lru_phase(const Params& p, LAS unsigned char* lds) {
    int tid_l = threadIdx.x; asm volatile("" : "+v"(tid_l)); const int tid = tid_l, lane = tid & 63, wid = tid >> 6, li = lane & 15, g4 = lane >> 4;
    const bf16_t* Z = (const bf16_t*)(p.ws + WS_R1);
    bf16_t* Y = (bf16_t*)(p.ws + WS_Y);
    LAS float* ucf = (LAS float*)lds;
    LAS bf16_t* ucb = (LAS bf16_t*)(lds + 32768);
    LAS bf16_t* wcat = (LAS bf16_t*)(lds + 32768 + 18432);
    LAS float* af = (LAS float*)(lds + 32768 + 2 * 18432);
    LAS float* wst = (LAS float*)(lds + 32768 + 2 * 18432 + 32768);
    LAS float* carry = wst + 1024;
    for (int unit = blockIdx.x; unit < NB * 8; unit += gridDim.x) {
        const int b = unit >> 3, gb = unit & 7;
        __syncthreads();
        for (int idx = tid; idx < 64 * 128; idx += 512) {
            const int n = idx & 127, c = idx >> 7;
            const float w = (n < 64) ? p.in[6][((size_t)gb * 64 + c) * 64 + n] : p.in[8][((size_t)gb * 64 + c) * 64 + (n - 64)];
            wcat[n * 72 + c] = (bf16_t)f2bf(w);
        }
        if (tid < 128) carry[tid] = 0.f;
        const int ch = gb * 64 + lane;
        const float cw0 = p.in[4][0 * 512 + ch], cw1 = p.in[4][1 * 512 + ch], cw2 = p.in[4][2 * 512 + ch], cw3 = p.in[4][3 * 512 + ch], cb = p.in[5][ch];
        float ba[4], bi[4], sp8[4];
#pragma unroll
        for (int nt = 0; nt < 4; ++nt) {
            const int d = gb * 64 + 16 * nt + li;
            ba[nt] = p.in[7][d]; bi[nt] = p.in[9][d];
            const float lam = p.in[10][d];
            sp8[nt] = 8.0f * (fmaxf(-lam, 0.f) + log1pf(expf(-fabsf(lam))));
        }
        __syncthreads();
        const bf16_t* zb = Z + (size_t)b * SEQ * ABN;
        unsigned un[10];
        {
            const int tw = 16 * wid;
#pragma unroll
            for (int j = 0; j < 10; ++j) {
                const int r0 = tw - 3 + 2 * j, r1 = r0 + 1;
                const unsigned a = (r0 >= 0) ? zb[(size_t)r0 * ABN + ch] : 0u;
                const unsigned bb = (j < 9 && r1 >= 0) ? zb[(size_t)r1 * ABN + ch] : 0u;
                un[j] = a | (bb << 16);
            }
        }
        for (int tc = 0; tc < SEQ / 128; ++tc) {
            const int t0 = tc * 128, tw = t0 + 16 * wid;
            unsigned uq[10], gq[8];
#pragma unroll
            for (int j = 0; j < 10; ++j) uq[j] = un[j];
#pragma unroll
            for (int j = 0; j < 8; ++j) { const unsigned a = zb[(size_t)(tw + 2 * j) * ABN + 512 + ch], bb = zb[(size_t)(tw + 2 * j + 1) * ABN + 512 + ch]; gq[j] = a | (bb << 16); }
            if (tc + 1 < SEQ / 128) {
#pragma unroll
                for (int j = 0; j < 10; ++j) {
                    const unsigned a = zb[(size_t)(tw + 128 - 3 + 2 * j) * ABN + ch];
                    const unsigned bb = (j < 9) ? zb[(size_t)(tw + 128 - 3 + 2 * j + 1) * ABN + ch] : 0u;
                    un[j] = a | (bb << 16);
                }
            }
#define UQ(k) (((k) & 1) ? __uint_as_float(uq[(k) >> 1] & 0xffff0000u) : __uint_as_float(uq[(k) >> 1] << 16))
#define GQ(k) (((k) & 1) ? __uint_as_float(gq[(k) >> 1] & 0xffff0000u) : __uint_as_float(gq[(k) >> 1] << 16))
            {
#pragma unroll
                for (int i = 0; i < 16; ++i) {
                    const float uc = cb + cw0 * UQ(i) + cw1 * UQ(i + 1) + cw2 * UQ(i + 2) + cw3 * UQ(i + 3);
                    const int r = 16 * wid + i;
                    ucf[r * 64 + lane] = uc; ucb[r * 72 + lane] = (bf16_t)f2bf(uc);
                }
            }
            __syncthreads();
            {
                f32x4 acc[8];
                bf16x8 af_[2];
#pragma unroll
                for (int ks = 0; ks < 2; ++ks) af_[ks] = *(LAS const bf16x8*)((LAS const unsigned char*)ucb + ((16 * wid + li) * 72 + 32 * ks + 8 * g4) * 2);
#pragma unroll
                for (int nt = 0; nt < 8; ++nt) {
                    acc[nt] = (f32x4){0.f, 0.f, 0.f, 0.f};
#pragma unroll
                    for (int ks = 0; ks < 2; ++ks) {
                        const bf16x8 bfr = *(LAS const bf16x8*)((LAS const unsigned char*)wcat + ((16 * nt + li) * 72 + 32 * ks + 8 * g4) * 2);
                        acc[nt] = __builtin_amdgcn_mfma_f32_16x16x32_bf16(af_[ks], bfr, acc[nt], 0, 0, 0);
                    }
                }
#pragma unroll
                for (int nt = 0; nt < 4; ++nt)
#pragma unroll
                    for (int e = 0; e < 4; ++e) {
                        const int r = 16 * wid + 4 * g4 + e, d = 16 * nt + li;
                        const float rg = sigmoidf_(acc[nt][e] + ba[nt]), ig = sigmoidf_(acc[nt + 4][e] + bi[nt]);
                        const float la = -sp8[nt] * rg;
                        const float a = ex2(LOG2E * la);
                        const float mult = __builtin_amdgcn_sqrtf(fmaxf(one_minus_exp(2.0f * la), 0.f));
                        const float uc = ucf[r * 64 + d];
                        ucf[r * 64 + d] = mult * ig * uc;
                        af[r * 64 + d] = a;
                    }
            }
            __syncthreads();
            {
                float A = 1.f, H = 0.f;
#pragma unroll 4
                for (int i = 0; i < 16; ++i) { const int r = 16 * wid + i; const float a = af[r * 64 + lane], x = ucf[r * 64 + lane]; H = a * H + x; A *= a; }
                wst[(wid * 2 + 0) * 64 + lane] = A; wst[(wid * 2 + 1) * 64 + lane] = H;
            }
            __syncthreads();
            {
                float h = carry[(tc & 1) * 64 + lane];
                for (int w = 0; w < wid; ++w) h = wst[(w * 2 + 0) * 64 + lane] * h + wst[(w * 2 + 1) * 64 + lane];
#pragma unroll
                for (int i = 0; i < 16; ++i) {
                    const int r = 16 * wid + i;
                    const float a = af[r * 64 + lane], x = ucf[r * 64 + lane];
                    h = a * h + x;
                    Y[((size_t)b * SEQ + tw + i) * DM + ch] = (bf16_t)f2bf(h * gelu_tanh(GQ(i)));
                }
                if (wid == 7) carry[((tc + 1) & 1) * 64 + lane] = h;
            }
            __syncthreads();
        }
    }
}

struct FoxFn {
    LAS const float* cs; int key0, row0; bool domask;
    __device__ __forceinline__ f32x4 init(int kt) const { return *(LAS const f32x4*)(cs + 16 * kt + (key0 & 12)); }
    __device__ __forceinline__ f32x4 apply(f32x4 s, int qt, int kt) const {
        f32x4 t = s;
        if (domask) {
            const int row = row0 + 16 * qt, kb = key0 + 16 * kt;
#pragma unroll
            for (int e = 0; e < 4; ++e) if (kb + e > row) t[e] = -INFINITY;
        }
        return t;
    }
};

__device__ __forceinline__ void fox_phase(const Params& p, LAS unsigned char* lds) {
    int tid_l = threadIdx.x; asm volatile("" : "+v"(tid_l)); const int tid = tid_l, lane = tid & 63, wid = __builtin_amdgcn_readfirstlane(tid >> 6), li = lane & 15, g = lane >> 4;
    const bf16_t* Z = (const bf16_t*)(p.ws + WS_R1);
    bf16_t* Y = (bf16_t*)(p.ws + WS_Y);
    const float* cs2 = (const float*)(p.ws + WS_CS);
    LAS unsigned char* Ks = lds;
    LAS unsigned char* Vs = lds + 20480;
    LAS float* csl = (LAS float*)(lds + 40960);
    const int nunits = NB * 8 * 4;
    const bool xmap = (gridDim.x == 256);
    const int vcu = __builtin_amdgcn_readfirstlane(*(volatile LAS int*)(lds + LDS_BYTES - 48));
    for (int unit = blockIdx.x; unit < nunits; unit += gridDim.x) {
        int bh = unit >> 2, pair = unit & 3;
        if (xmap) { bh = (vcu & 7) * 32 + (vcu >> 3); pair = unit >> 8; }
        const int b = bh >> 3, h = bh & 7;
        const bf16_t* zb = Z + (size_t)b * SEQ * ABN;
        for (int half = 0; half < 2; ++half) {
            const int qblk = half ? (7 - pair) : pair;
            const int q0 = qblk * 256, rw0 = q0 + 32 * wid;
            bf16x8 Qf[2][2];
#pragma unroll
            for (int qt = 0; qt < 2; ++qt)
#pragma unroll
                for (int ks = 0; ks < 2; ++ks) Qf[qt][ks] = *(const bf16x8*)(zb + (size_t)(rw0 + 16 * qt + li) * ABN + 1024 + 64 * h + 32 * ks + 8 * g);
            f32x4 O[2][4]; float mrow[2], lsum[2];
#pragma unroll
            for (int qt = 0; qt < 2; ++qt) { mrow[qt] = -INFINITY; lsum[qt] = 0.f;
#pragma unroll
                for (int dt = 0; dt < 4; ++dt) O[qt][dt] = (f32x4){0.f, 0.f, 0.f, 0.f}; }
            const int nst = 2 * (qblk + 1);
            u32x4 rk[2], rv[2]; float rc = 0.f;
#pragma unroll
            for (int i = 0; i < 2; ++i) { const int c = tid + 512 * i, row = c >> 3, ch = c & 7; const bf16_t* src = zb + (size_t)row * ABN + 1536 + 64 * h + 8 * ch; rk[i] = *(const u32x4*)src; rv[i] = *(const u32x4*)(src + 512); }
            if (tid < 128) rc = cs2[(size_t)bh * SEQ + tid];
            for (int st = 0; st < nst; ++st) {
                const int k0 = st * 128;
                __syncthreads();
#pragma unroll
                for (int i = 0; i < 2; ++i) { const int c = tid + 512 * i, row = c >> 3, ch = c & 7; *(LAS u32x4*)(Ks + row * 160 + ch * 16) = rk[i]; *(LAS u32x4*)(Vs + row * 160 + ch * 16) = rv[i]; }
                if (tid < 128) csl[tid] = -rc;
                __syncthreads();
                if (st + 1 < nst) {
#pragma unroll
                    for (int i = 0; i < 2; ++i) { const int c = tid + 512 * i, row = c >> 3, ch = c & 7; const bf16_t* src = zb + (size_t)(k0 + 128 + row) * ABN + 1536 + 64 * h + 8 * ch; rk[i] = *(const u32x4*)src; rv[i] = *(const u32x4*)(src + 512); }
                    if (tid < 128) rc = cs2[(size_t)bh * SEQ + k0 + 128 + tid];
                }
                if (k0 <= rw0 + 31) {
                    FoxFn fn; fn.cs = csl; fn.key0 = k0 + 4 * g; fn.row0 = rw0 + li; fn.domask = (k0 + 127 > rw0);
                    attn_stage<4, 2, 4, 160, 160>(O, mrow, lsum, Qf, Ks, Vs, fn, lane);
                    if (k0 + 64 <= rw0 + 31) {
                        fn.cs = csl + 64; fn.key0 = k0 + 64 + 4 * g;
                        attn_stage<4, 2, 4, 160, 160>(O, mrow, lsum, Qf, Ks + 64 * 160, Vs + 64 * 160, fn, lane);
                    }
                }
            }
#pragma unroll
            for (int qt = 0; qt < 2; ++qt) {
                float l = lsum[qt]; l = quad_sum(l);
                const float inv = 1.0f / l;
                bf16_t* dst = Y + ((size_t)b * SEQ + rw0 + 16 * qt + li) * DM + 512 + 64 * h + 4 * g;
#pragma unroll
                for (int dt = 0; dt < 4; ++dt) { const f32x4 o = O[qt][dt] * inv; u32x2 w; w.x = pk2(o[0], o[1]); w.y = pk2(o[2], o[3]); *(u32x2*)(dst + 16 * dt) = w; }
            }
        }
    }
    __syncthreads();
}

struct BandFn {
    __device__ __forceinline__ f32x4 init(int) const { return (f32x4){0.f, 0.f, 0.f, 0.f}; }
    int jk0, jq, maxd; bool domask;
    __device__ __forceinline__ f32x4 apply(f32x4 s, int qt, int kt) const {
        f32x4 t = s;
        if (!domask) return t;
#pragma unroll
        for (int e = 0; e < 4; ++e) { const int jk = jk0 + 16 * kt + e, d = jq + 16 * qt - jk; if (jk < 0 || d < 0 || d > maxd) t[e] = -INFINITY; }
        return t;
    }
};

template <int QT>
__device__ __forceinline__ void band_job(const bf16_t* zb, int qcol, int kcol, int vcol, int dil, int r, int jq0, int maxd, int T0, bool first,
                                         LAS unsigned char* wl, LAS float* Ost, LAS float* mst, LAS float* lst, int lane) {
    const int li = lane & 15, g = lane >> 4, q4 = li >> 2, pp = li & 3;
    const int jks = jq0 + 16 * QT - 160;
    u32x4 rvA[4], rvB[4];
#define BAND_VLOAD(dst, s) do { _Pragma("unroll") for (int i = 0; i < 4; ++i) { const int pc = lane + 64 * i, row = pc >> 3, ch = pc & 7, jk = jks + 32 * (s) + row; \
        dst[i] = *(const u32x4*)(zb + (size_t)((jk < 0 ? 0 : jk) * dil + r) * CDN + vcol + 8 * ch); } } while (0)
#define BAND_VSTORE(src, s) do { LAS unsigned char* vb_ = wl + ((s) & 1) * 5120; _Pragma("unroll") for (int i = 0; i < 4; ++i) { const int pc = lane + 64 * i, row = pc >> 3, ch = pc & 7; *(LAS u32x4*)(vb_ + row * 160 + ch * 16) = src[i]; } } while (0)
    BAND_VLOAD(rvA, 0); BAND_VLOAD(rvB, 1);
    bf16x8 Qf[QT][2];
#pragma unroll
    for (int qt = 0; qt < QT; ++qt)
#pragma unroll
        for (int ks = 0; ks < 2; ++ks) Qf[qt][ks] = *(const bf16x8*)(zb + (size_t)((jq0 + 16 * qt + li) * dil + r) * CDN + qcol + 32 * ks + 8 * g);
    f32x4 S[QT][10];
#pragma unroll
    for (int half = 0; half < 2; ++half) {
        bf16x8 kf[5][2];
#pragma unroll
        for (int k5 = 0; k5 < 5; ++k5) {
            const int jk = jks + 16 * (5 * half + k5) + li;
#pragma unroll
            for (int ks = 0; ks < 2; ++ks) {
                kf[k5][ks] = *(const bf16x8*)(zb + (size_t)((jk < 0 ? 0 : jk) * dil + r) * CDN + kcol + 32 * ks + 8 * g);
            }
        }
#pragma unroll
        for (int k5 = 0; k5 < 5; ++k5)
#pragma unroll
            for (int qt = 0; qt < QT; ++qt) {
                f32x4 acc = (f32x4){0.f, 0.f, 0.f, 0.f};
#pragma unroll
                for (int ks = 0; ks < 2; ++ks) acc = __builtin_amdgcn_mfma_f32_16x16x32_bf16(kf[k5][ks], Qf[qt][ks], acc, 0, 0, 0);
                S[qt][5 * half + k5] = acc;
            }
    }
    const bool early = (jks < 0);
#pragma unroll
    for (int kt = 0; kt < 10; ++kt) {
        if (kt < 2 || kt >= 8 || early) {
#pragma unroll
            for (int qt = 0; qt < QT; ++qt)
#pragma unroll
                for (int e = 0; e < 4; ++e) { const int jk = jks + 16 * kt + 4 * g + e, d = jq0 + 16 * qt + li - jk; if (jk < 0 || d < 0 || d > maxd) S[qt][kt][e] = -INFINITY; }
        }
    }
    float mrow[QT], lsum[QT];
#pragma unroll
    for (int qt = 0; qt < QT; ++qt) {
        float mx = -INFINITY;
#pragma unroll
        for (int kt = 0; kt < 10; ++kt) { mx = max3f(mx, S[qt][kt][0], S[qt][kt][1]); mx = max3f(mx, S[qt][kt][2], S[qt][kt][3]); }
        mx = quad_max(mx);
        float ps = 0.f;
#pragma unroll
        for (int kt = 0; kt < 10; ++kt)
#pragma unroll
            for (int e = 0; e < 4; ++e) { const float pv = ex2(S[qt][kt][e] - mx); S[qt][kt][e] = pv; ps += pv; }
        mrow[qt] = mx; lsum[qt] = ps;
    }
    f32x4 O[QT][4];
#pragma unroll
    for (int qt = 0; qt < QT; ++qt)
#pragma unroll
        for (int dt = 0; dt < 4; ++dt) O[qt][dt] = (f32x4){0.f, 0.f, 0.f, 0.f};
#pragma unroll
    for (int s = 0; s < 5; ++s) {
        if (s & 1) BAND_VSTORE(rvB, s); else BAND_VSTORE(rvA, s);
        if (s + 2 < 5) { if (s & 1) BAND_VLOAD(rvB, s + 2); else BAND_VLOAD(rvA, s + 2); }
        bf16x8 Pf[QT];
#pragma unroll
        for (int qt = 0; qt < QT; ++qt) {
            u32x4 w; w.x = pk2(S[qt][2 * s][0], S[qt][2 * s][1]); w.y = pk2(S[qt][2 * s][2], S[qt][2 * s][3]);
            w.z = pk2(S[qt][2 * s + 1][0], S[qt][2 * s + 1][1]); w.w = pk2(S[qt][2 * s + 1][2], S[qt][2 * s + 1][3]);
            Pf[qt] = __builtin_bit_cast(bf16x8, w);
        }
        LAS const unsigned char* Vs = wl + (s & 1) * 5120;
#pragma unroll
        for (int dt = 0; dt < 4; ++dt) {
            LAS const unsigned char* vp = Vs + (4 * g + q4) * 160 + (16 * dt + 4 * pp) * 2;
            const s16x4 a1 = vtr(vp), a2 = vtr(vp + 16 * 160);
            const bf16x8 vf = (bf16x8){a1[0], a1[1], a1[2], a1[3], a2[0], a2[1], a2[2], a2[3]};
#pragma unroll
            for (int qt = 0; qt < QT; ++qt) O[qt][dt] = __builtin_amdgcn_mfma_f32_16x16x32_bf16(vf, Pf[qt], O[qt][dt], 0, 0, 0);
        }
    }
#undef BAND_VLOAD
#undef BAND_VSTORE
#pragma unroll
    for (int qt = 0; qt < QT; ++qt) {
        float l = lsum[qt]; l = quad_sum(l);
        const int tl = (jq0 + 16 * qt + li) * dil + r - T0;
        float fo = 0.f, fn_ = 1.f, mn = mrow[qt], ln = l;
        if (!first) { const float mo = mst[tl], lo = lst[tl]; mn = fmaxf(mo, mrow[qt]); fo = ex2(mo - mn); fn_ = ex2(mrow[qt] - mn); ln = lo * fo + l * fn_; }
#pragma unroll
        for (int dt = 0; dt < 4; ++dt) {
            LAS f32x4* sp = (LAS f32x4*)(Ost + tl * 64 + 16 * dt + 4 * g);
            f32x4 o = O[qt][dt] * fn_;
            if (!first) o = o + (*sp) * fo;
            *sp = o;
        }
        if (g == 0) { mst[tl] = mn; lst[tl] = ln; }
    }
}

__device__ __forceinline__ const bf16_t* zhead(const bf16_t* Z, int b, int hb) { return Z + ((size_t)(b * 36 + hb) * SEQ) * 64; }
constexpr size_t WS_P16 = WS_R1 + 320 * MiB;
constexpr size_t WS_M16 = WS_R1 + 400 * MiB;
constexpr size_t WS_L16 = WS_R1 + 404 * MiB;
__device__ __forceinline__ void d16_job(LAS const unsigned char* Kc, LAS const unsigned char* Vc, const bf16_t* qh, int r, int qt, bf16_t* Pb, float* Mb, float* Lb, int lane) {
    const int li = lane & 15, g = lane >> 4, q4 = li >> 2, pp = li & 3;
    const int token = (16 * qt + li) * 16 + r;
    bf16x8 Qf[2];
#pragma unroll
    for (int ks = 0; ks < 2; ++ks) Qf[ks] = *(const bf16x8*)(qh + (unsigned)(token * 64 + 32 * ks + 8 * g));
    bf16x8 kf[8][2];
    LAS const unsigned char* kbase = Kc + li * 160 + 16 * g;
#pragma unroll
    for (int kt = 0; kt < 8; ++kt)
#pragma unroll
        for (int ks = 0; ks < 2; ++ks) kf[kt][ks] = *(LAS const bf16x8*)(kbase + (16 * kt) * 160 + 64 * ks);
    __builtin_amdgcn_sched_barrier(0);
    f32x4 S[8];
#pragma unroll
    for (int kt = 0; kt < 8; ++kt) {
        f32x4 acc = (f32x4){0.f, 0.f, 0.f, 0.f};
#pragma unroll
        for (int ks = 0; ks < 2; ++ks) acc = __builtin_amdgcn_mfma_f32_16x16x32_bf16(kf[kt][ks], Qf[ks], acc, 0, 0, 0);
        S[kt] = acc;
    }
    float mx = -INFINITY;
#pragma unroll
    for (int kt = 0; kt < 8; ++kt) {
#pragma unroll
        for (int e = 0; e < 4; ++e) if (16 * kt + 4 * g + e > 16 * qt + li) S[kt][e] = -INFINITY;
        mx = max3f(mx, S[kt][0], S[kt][1]); mx = max3f(mx, S[kt][2], S[kt][3]);
    }
    mx = quad_max(mx);
    float ps = 0.f;
#pragma unroll
    for (int kt = 0; kt < 8; ++kt)
#pragma unroll
        for (int e = 0; e < 4; ++e) { const float pv = ex2(S[kt][e] - mx); S[kt][e] = pv; ps += pv; }
    const float l = quad_sum(ps);
    f32x4 O[4];
#pragma unroll
    for (int dt = 0; dt < 4; ++dt) O[dt] = (f32x4){0.f, 0.f, 0.f, 0.f};
    LAS const unsigned char* vbase = Vc + (4 * g + q4) * 160 + 8 * pp;
#pragma unroll
    for (int s = 0; s < 4; ++s) {
        s16x4 va[4][2];
#pragma unroll
        for (int dt = 0; dt < 4; ++dt) { va[dt][0] = vtr(vbase + (32 * s) * 160 + 32 * dt); va[dt][1] = vtr(vbase + (32 * s + 16) * 160 + 32 * dt); }
        u32x4 w; w.x = pk2(S[2 * s][0], S[2 * s][1]); w.y = pk2(S[2 * s][2], S[2 * s][3]); w.z = pk2(S[2 * s + 1][0], S[2 * s + 1][1]); w.w = pk2(S[2 * s + 1][2], S[2 * s + 1][3]);
        const bf16x8 Pf = __builtin_bit_cast(bf16x8, w);
#pragma unroll
        for (int dt = 0; dt < 4; ++dt) {
            const bf16x8 vf = (bf16x8){va[dt][0][0], va[dt][0][1], va[dt][0][2], va[dt][0][3], va[dt][1][0], va[dt][1][1], va[dt][1][2], va[dt][1][3]};
            O[dt] = __builtin_amdgcn_mfma_f32_16x16x32_bf16(vf, Pf, O[dt], 0, 0, 0);
        }
    }
    const float inv = 1.0f / l;
    bf16_t* dst = Pb + (size_t)token * 512 + 4 * g;
#pragma unroll
    for (int dt = 0; dt < 4; ++dt) { const f32x4 o = O[dt] * inv; u32x2 w2; w2.x = pk2(o[0], o[1]); w2.y = pk2(o[2], o[3]); *(u32x2*)(dst + 16 * dt) = w2; }
    if (g == 0) { Mb[(size_t)token * 8] = mx; Lb[(size_t)token * 8] = l; }
}
__device__ __forceinline__ void d16_phase(const Params& p, LAS unsigned char* lds) {
    int tid_l = threadIdx.x; asm volatile("" : "+v"(tid_l)); const int tid = tid_l, lane = tid & 63, wid = __builtin_amdgcn_readfirstlane(tid >> 6);
    const bf16_t* Z = (const bf16_t*)(p.ws + WS_R1);
    LAS unsigned char* Ks = lds;
    LAS unsigned char* Vs = lds + 40960;
    for (int bh = blockIdx.x; bh < NB * 8; bh += gridDim.x) {
        const int b = bh >> 3, h = bh & 7;
        const bf16_t* qh = zhead(Z, b, h); const bf16_t* kh_ = zhead(Z, b, 8 + h); const bf16_t* vh_ = zhead(Z, b, 16 + h);
        bf16_t* Pb = (bf16_t*)(p.ws + WS_P16) + (size_t)b * SEQ * 512 + 64 * h;
        float* Mb = (float*)(p.ws + WS_M16) + (size_t)b * SEQ * 8 + h;
        float* Lb = (float*)(p.ws + WS_L16) + (size_t)b * SEQ * 8 + h;
        u32x4 rk[4], rv[4];
#define D16_LOAD(cp) do { _Pragma("unroll") for (int i = 0; i < 4; ++i) { const int c = tid + 512 * i, row = c >> 3, ch = c & 7, token = (row & 127) * 16 + 2 * (cp) + (row >> 7); \
            const unsigned so = (unsigned)(token * 64 + 8 * ch); rk[i] = *(const u32x4*)(kh_ + so); rv[i] = *(const u32x4*)(vh_ + so); } } while (0)
        D16_LOAD(0);
        for (int cp = 0; cp < 8; ++cp) {
            __syncthreads();
#pragma unroll
            for (int i = 0; i < 4; ++i) { const int c = tid + 512 * i, row = c >> 3, ch = c & 7; *(LAS u32x4*)(Ks + row * 160 + ch * 16) = rk[i]; *(LAS u32x4*)(Vs + row * 160 + ch * 16) = rv[i]; }
            __syncthreads();
            if (cp + 1 < 8) D16_LOAD(cp + 1);
            d16_job(Ks, Vs, qh, 2 * cp, wid, Pb, Mb, Lb, lane);
            d16_job(Ks + 128 * 160, Vs + 128 * 160, qh, 2 * cp + 1, 7 - wid, Pb, Mb, Lb, lane);
        }
#undef D16_LOAD
    }
    __syncthreads();
}

__device__ __forceinline__ void swa_phase(const Params& p, LAS unsigned char* lds) {
    int tid_l = threadIdx.x; asm volatile("" : "+v"(tid_l)); const int tid = tid_l, lane = tid & 63, wid = __builtin_amdgcn_readfirstlane(tid >> 6), li = lane & 15, g = lane >> 4, q4 = li >> 2, pp = li & 3;
    const bf16_t* Z = (const bf16_t*)(p.ws + WS_R1);
    bf16_t* Y = (bf16_t*)(p.ws + WS_Y);
    LAS unsigned char* Ks = lds;
    LAS unsigned char* Vs = lds + 61440;
    const int vcu = __builtin_amdgcn_readfirstlane(*(volatile LAS int*)(lds + LDS_BYTES - 48));
    for (int unit = blockIdx.x; unit < NB * 8 * 2; unit += gridDim.x) {
        int u2 = unit;
        if (gridDim.x == 256) { const int x = vcu & 7, v = vcu >> 3, i = unit >> 8; u2 = ((x * 4 + (v >> 3)) * 8 + (v & 7)) * 2 + i; }
        const int kvh = u2 & 1, bt = u2 >> 1, b = bt >> 3, tb = bt & 7, T0 = tb * 256;
        const bf16_t* kh_ = zhead(Z, b, 32 + kvh); const bf16_t* vh_ = zhead(Z, b, 34 + kvh);
        {
            u32x4 rk[6], rv[6];
#pragma unroll
            for (int k = 0; k < 6; ++k) {
                int tok = T0 - 128 + (tid >> 3) + 64 * k; tok = tok < 0 ? 0 : tok;
                const unsigned so = (unsigned)(tok * 64 + 8 * (tid & 7));
                rk[k] = *(const u32x4*)(kh_ + so); rv[k] = *(const u32x4*)(vh_ + so);
            }
            __syncthreads();
            LAS unsigned char* lp = Ks + (tid >> 3) * 160 + (tid & 7) * 16;
#pragma unroll
            for (int k = 0; k < 6; ++k) { *(LAS u32x4*)(lp + 64 * 160 * k) = rk[k]; *(LAS u32x4*)(lp + 61440 + 64 * 160 * k) = rv[k]; }
            __syncthreads();
        }
        const bool early = (T0 == 0);
        LAS const unsigned char* kbase = Ks + (32 * wid + li) * 160 + 16 * g;
        LAS const unsigned char* vbase = Vs + (32 * wid + 4 * g + q4) * 160 + 8 * pp;
        for (int qh = 0; qh < 4; ++qh) {
            const int h8 = 4 * kvh + qh;
            const bf16_t* qb_ = zhead(Z, b, 24 + h8) + (T0 + 32 * wid) * 64;
            bf16x8 Qf[2][2];
#pragma unroll
            for (int qt = 0; qt < 2; ++qt)
#pragma unroll
                for (int ks = 0; ks < 2; ++ks) Qf[qt][ks] = *(const bf16x8*)(qb_ + (unsigned)((16 * qt + li) * 64 + 32 * ks + 8 * g));
            f32x4 S[2][10];
            {
                bf16x8 kf[2][2][2];
#pragma unroll
                for (int t = 0; t < 2; ++t)
#pragma unroll
                    for (int ks = 0; ks < 2; ++ks) kf[0][t][ks] = *(LAS const bf16x8*)(kbase + (16 * t) * 160 + 64 * ks);
#pragma unroll
                for (int kb = 0; kb < 5; ++kb) {
                    if (kb + 1 < 5) {
#pragma unroll
                        for (int t = 0; t < 2; ++t)
#pragma unroll
                            for (int ks = 0; ks < 2; ++ks) kf[(kb + 1) & 1][t][ks] = *(LAS const bf16x8*)(kbase + (16 * (2 * (kb + 1) + t)) * 160 + 64 * ks);
                    }
                    __builtin_amdgcn_sched_barrier(0); __builtin_amdgcn_s_setprio(1);
#pragma unroll
                    for (int t = 0; t < 2; ++t)
#pragma unroll
                        for (int qt = 0; qt < 2; ++qt) {
                            f32x4 acc = (f32x4){0.f, 0.f, 0.f, 0.f};
#pragma unroll
                            for (int ks = 0; ks < 2; ++ks) acc = __builtin_amdgcn_mfma_f32_16x16x32_bf16(kf[kb & 1][t][ks], Qf[qt][ks], acc, 0, 0, 0);
                            S[qt][2 * kb + t] = acc;
                        }
__builtin_amdgcn_s_setprio(0); __builtin_amdgcn_sched_barrier(0);
                }
            }
#pragma unroll
            for (int kt = 0; kt < 10; ++kt) {
                if (kt < 2 || kt >= 8 || early) {
#pragma unroll
                    for (int qt = 0; qt < 2; ++qt)
#pragma unroll
                        for (int e = 0; e < 4; ++e) { const int kr = 16 * kt + 4 * g + e - 128, d = 16 * qt + li - kr; if (d < 0 || d > 127 || T0 + 32 * wid + kr < 0) S[qt][kt][e] = -INFINITY; }
                }
            }
            const float sink2 = p.in[15][h8] * LOG2E;
            float scl[2];
            bf16x8 Pf[2][5];
#pragma unroll
            for (int qt = 0; qt < 2; ++qt) {
                float mx = -INFINITY;
#pragma unroll
                for (int kt = 0; kt < 10; ++kt) { mx = max3f(mx, S[qt][kt][0], S[qt][kt][1]); mx = max3f(mx, S[qt][kt][2], S[qt][kt][3]); }
                mx = max2f(quad_max(mx), sink2);
                float ps = 0.f;
#pragma unroll
                for (int kt = 0; kt < 10; ++kt)
#pragma unroll
                    for (int e = 0; e < 4; ++e) { const float pv = ex2(S[qt][kt][e] - mx); S[qt][kt][e] = pv; ps += pv; }
                scl[qt] = 1.0f / (quad_sum(ps) + ex2(sink2 - mx));
#pragma unroll
                for (int s = 0; s < 5; ++s) {
                    u32x4 w; w.x = pk2(S[qt][2 * s][0], S[qt][2 * s][1]); w.y = pk2(S[qt][2 * s][2], S[qt][2 * s][3]);
                    w.z = pk2(S[qt][2 * s + 1][0], S[qt][2 * s + 1][1]); w.w = pk2(S[qt][2 * s + 1][2], S[qt][2 * s + 1][3]);
                    Pf[qt][s] = __builtin_bit_cast(bf16x8, w);
                }
            }
            f32x4 O[2][4];
#pragma unroll
            for (int qt = 0; qt < 2; ++qt)
#pragma unroll
                for (int dt = 0; dt < 4; ++dt) O[qt][dt] = (f32x4){0.f, 0.f, 0.f, 0.f};
            {
                s16x4 va[2][4][2];
#pragma unroll
                for (int dt = 0; dt < 4; ++dt) { va[0][dt][0] = vtr(vbase + 32 * dt); va[0][dt][1] = vtr(vbase + 16 * 160 + 32 * dt); }
#pragma unroll
                for (int s = 0; s < 5; ++s) {
                    if (s + 1 < 5) {
#pragma unroll
                        for (int dt = 0; dt < 4; ++dt) { va[(s + 1) & 1][dt][0] = vtr(vbase + (32 * (s + 1)) * 160 + 32 * dt); va[(s + 1) & 1][dt][1] = vtr(vbase + (32 * (s + 1) + 16) * 160 + 32 * dt); }
                    }
                    __builtin_amdgcn_sched_barrier(0); __builtin_amdgcn_s_setprio(1);
#pragma unroll
                    for (int dt = 0; dt < 4; ++dt) {
                        const s16x4 a1 = va[s & 1][dt][0], a2 = va[s & 1][dt][1];
                        const bf16x8 vf = (bf16x8){a1[0], a1[1], a1[2], a1[3], a2[0], a2[1], a2[2], a2[3]};
#pragma unroll
                        for (int qt = 0; qt < 2; ++qt) O[qt][dt] = __builtin_amdgcn_mfma_f32_16x16x32_bf16(vf, Pf[qt][s], O[qt][dt], 0, 0, 0);
                    }
__builtin_amdgcn_s_setprio(0); __builtin_amdgcn_sched_barrier(0);
                }
            }
            bf16_t* yb_ = Y + ((size_t)b * SEQ + T0 + 32 * wid) * DM + 512 + 64 * h8;
#pragma unroll
            for (int qt = 0; qt < 2; ++qt)
#pragma unroll
                for (int dt = 0; dt < 4; ++dt) { const f32x4 o = O[qt][dt] * scl[qt]; u32x2 w; w.x = pk2(o[0], o[1]); w.y = pk2(o[2], o[3]); *(u32x2*)(yb_ + (unsigned)((16 * qt + li) * DM + 16 * dt + 4 * g)) = w; }
        }
    }
    __syncthreads();
}

constexpr size_t WS_P4 = WS_R1 + 408 * MiB, WS_M4 = WS_R1 + 480 * MiB, WS_L4 = WS_R1 + 484 * MiB;
__device__ __forceinline__ void d4_phase(const Params& p, LAS unsigned char* lds) {
    int tid_l = threadIdx.x; asm volatile("" : "+v"(tid_l)); const int tid = tid_l, lane = tid & 63, wid = __builtin_amdgcn_readfirstlane(tid >> 6), li = lane & 15, g = lane >> 4, q4 = li >> 2, pp = li & 3;
    const bf16_t* Z = (const bf16_t*)(p.ws + WS_R1);
    LAS unsigned char* Ks = lds;
    LAS unsigned char* Vs = lds + 61440;
    const int vcu = __builtin_amdgcn_readfirstlane(*(volatile LAS int*)(lds + LDS_BYTES - 48));
#define D4_PARAMS(u_, b_, hq_, r4_, T0_) int b_, hq_, r4_, T0_; { int bh_ = (u_) >> 3, sub_ = (u_) & 7; if (gridDim.x == 256) { bh_ = (vcu & 7) * 32 + (vcu >> 3); sub_ = (u_) >> 8; } \
        b_ = bh_ >> 3; hq_ = bh_ & 7; r4_ = sub_ >> 1; T0_ = (sub_ & 1) * 256; }
    u32x4 rk[6], rv[6]; bf16x8 Qn[2][2];
#define D4_FETCH(u_) do { D4_PARAMS(u_, fb, fh, fr, fT); const bf16_t* kh_ = zhead(Z, fb, 8 + fh); const bf16_t* vh_ = zhead(Z, fb, 16 + fh); \
        _Pragma("unroll") for (int k = 0; k < 6; ++k) { int j = fT - 128 + (tid >> 3) + 64 * k; j = j < 0 ? 0 : j; const unsigned so = (unsigned)((4 * j + fr) * 64 + 8 * (tid & 7)); \
            rk[k] = *(const u32x4*)(kh_ + so); rv[k] = *(const u32x4*)(vh_ + so); } \
        const bf16_t* qb_ = zhead(Z, fb, fh) + (4 * (fT + 32 * wid) + fr) * 64; \
        _Pragma("unroll") for (int qt = 0; qt < 2; ++qt) _Pragma("unroll") for (int ks = 0; ks < 2; ++ks) Qn[qt][ks] = *(const bf16x8*)(qb_ + (unsigned)(4 * (16 * qt + li) * 64 + 32 * ks + 8 * g)); } while (0)
    const int nunits = NB * 8 * 8;
    if ((int)blockIdx.x < nunits) D4_FETCH((int)blockIdx.x);
    for (int unit = blockIdx.x; unit < nunits; unit += gridDim.x) {
        D4_PARAMS(unit, b, hq, r4, T0);
        __syncthreads();
        {
            LAS unsigned char* lp = Ks + (tid >> 3) * 160 + (tid & 7) * 16;
#pragma unroll
            for (int k = 0; k < 6; ++k) { *(LAS u32x4*)(lp + 64 * 160 * k) = rk[k]; *(LAS u32x4*)(lp + 61440 + 64 * 160 * k) = rv[k]; }
        }
        bf16x8 Qf[2][2];
#pragma unroll
        for (int qt = 0; qt < 2; ++qt)
#pragma unroll
            for (int ks = 0; ks < 2; ++ks) Qf[qt][ks] = Qn[qt][ks];
        __syncthreads();
        if (unit + (int)gridDim.x < nunits) D4_FETCH(unit + (int)gridDim.x);
        const bool early = (T0 == 0);
        LAS const unsigned char* kbase = Ks + (32 * wid + li) * 160 + 16 * g;
        LAS const unsigned char* vbase = Vs + (32 * wid + 4 * g + q4) * 160 + 8 * pp;
        for (int once = 0; once < 1; ++once) {
            f32x4 S[2][10];
            {
                bf16x8 kf[2][2][2];
#pragma unroll
                for (int t = 0; t < 2; ++t)
#pragma unroll
                    for (int ks = 0; ks < 2; ++ks) kf[0][t][ks] = *(LAS const bf16x8*)(kbase + (16 * t) * 160 + 64 * ks);
#pragma unroll
                for (int kb = 0; kb < 5; ++kb) {
                    if (kb + 1 < 5) {
#pragma unroll
                        for (int t = 0; t < 2; ++t)
#pragma unroll
                            for (int ks = 0; ks < 2; ++ks) kf[(kb + 1) & 1][t][ks] = *(LAS const bf16x8*)(kbase + (16 * (2 * (kb + 1) + t)) * 160 + 64 * ks);
                    }
                    __builtin_amdgcn_sched_barrier(0); __builtin_amdgcn_s_setprio(1);
#pragma unroll
                    for (int t = 0; t < 2; ++t)
#pragma unroll
                        for (int qt = 0; qt < 2; ++qt) {
                            f32x4 acc = (f32x4){0.f, 0.f, 0.f, 0.f};
#pragma unroll
                            for (int ks = 0; ks < 2; ++ks) acc = __builtin_amdgcn_mfma_f32_16x16x32_bf16(kf[kb & 1][t][ks], Qf[qt][ks], acc, 0, 0, 0);
                            S[qt][2 * kb + t] = acc;
                        }
__builtin_amdgcn_s_setprio(0); __builtin_amdgcn_sched_barrier(0);
                }
            }
#pragma unroll
            for (int kt = 0; kt < 10; ++kt) {
                if (kt < 2 || kt >= 8 || early) {
#pragma unroll
                    for (int qt = 0; qt < 2; ++qt)
#pragma unroll
                        for (int e = 0; e < 4; ++e) { const int kr = 16 * kt + 4 * g + e - 128, d = 16 * qt + li - kr; if (d < 0 || d > 128 || T0 + 32 * wid + kr < 0) S[qt][kt][e] = -INFINITY; }
                }
            }
            float scl[2], mq[2], lq[2];
            bf16x8 Pf[2][5];
#pragma unroll
            for (int qt = 0; qt < 2; ++qt) {
                float mx = -INFINITY;
#pragma unroll
                for (int kt = 0; kt < 10; ++kt) { mx = max3f(mx, S[qt][kt][0], S[qt][kt][1]); mx = max3f(mx, S[qt][kt][2], S[qt][kt][3]); }
                mx = quad_max(mx);
                float ps = 0.f;
#pragma unroll
                for (int kt = 0; kt < 10; ++kt)
#pragma unroll
                    for (int e = 0; e < 4; ++e) { const float pv = ex2(S[qt][kt][e] - mx); S[qt][kt][e] = pv; ps += pv; }
                lq[qt] = quad_sum(ps); mq[qt] = mx; scl[qt] = 1.0f / lq[qt];
#pragma unroll
                for (int s = 0; s < 5; ++s) {
                    u32x4 w; w.x = pk2(S[qt][2 * s][0], S[qt][2 * s][1]); w.y = pk2(S[qt][2 * s][2], S[qt][2 * s][3]);
                    w.z = pk2(S[qt][2 * s + 1][0], S[qt][2 * s + 1][1]); w.w = pk2(S[qt][2 * s + 1][2], S[qt][2 * s + 1][3]);
                    Pf[qt][s] = __builtin_bit_cast(bf16x8, w);
                }
            }
            f32x4 O[2][4];
#pragma unroll
            for (int qt = 0; qt < 2; ++qt)
#pragma unroll
                for (int dt = 0; dt < 4; ++dt) O[qt][dt] = (f32x4){0.f, 0.f, 0.f, 0.f};
            {
                s16x4 va[2][4][2];
#pragma unroll
                for (int dt = 0; dt < 4; ++dt) { va[0][dt][0] = vtr(vbase + 32 * dt); va[0][dt][1] = vtr(vbase + 16 * 160 + 32 * dt); }
#pragma unroll
                for (int s = 0; s < 5; ++s) {
                    if (s + 1 < 5) {
#pragma unroll
                        for (int dt = 0; dt < 4; ++dt) { va[(s + 1) & 1][dt][0] = vtr(vbase + (32 * (s + 1)) * 160 + 32 * dt); va[(s + 1) & 1][dt][1] = vtr(vbase + (32 * (s + 1) + 16) * 160 + 32 * dt); }
                    }
                    __builtin_amdgcn_sched_barrier(0); __builtin_amdgcn_s_setprio(1);
#pragma unroll
                    for (int dt = 0; dt < 4; ++dt) {
                        const s16x4 a1 = va[s & 1][dt][0], a2 = va[s & 1][dt][1];
                        const bf16x8 vf = (bf16x8){a1[0], a1[1], a1[2], a1[3], a2[0], a2[1], a2[2], a2[3]};
#pragma unroll
                        for (int qt = 0; qt < 2; ++qt) O[qt][dt] = __builtin_amdgcn_mfma_f32_16x16x32_bf16(vf, Pf[qt][s], O[qt][dt], 0, 0, 0);
                    }
__builtin_amdgcn_s_setprio(0); __builtin_amdgcn_sched_barrier(0);
                }
            }
#pragma unroll
            for (int qt = 0; qt < 2; ++qt) {
                const size_t trow = (size_t)b * SEQ + 4 * (T0 + 32 * wid + 16 * qt + li) + r4;
                bf16_t* dst = (bf16_t*)(p.ws + WS_P4) + trow * 512 + 64 * hq + 4 * g;
#pragma unroll
                for (int dt = 0; dt < 4; ++dt) { const f32x4 o = O[qt][dt] * scl[qt]; u32x2 w; w.x = pk2(o[0], o[1]); w.y = pk2(o[2], o[3]); *(u32x2*)(dst + 16 * dt) = w; }
                if (g == 0) { ((float*)(p.ws + WS_M4))[trow * 8 + hq] = mq[qt]; ((float*)(p.ws + WS_L4))[trow * 8 + hq] = lq[qt]; }
            }
        }
    }
#undef D4_PARAMS
#undef D4_FETCH
    __syncthreads();
}

__device__ __forceinline__ void band_phase(const Params& p, LAS unsigned char* lds) {
    int tid_l = threadIdx.x; asm volatile("" : "+v"(tid_l)); const int tid = tid_l, lane = tid & 63, wid = __builtin_amdgcn_readfirstlane(tid >> 6), li = lane & 15, g = lane >> 4, q4 = li >> 2, pp = li & 3;
    const bf16_t* Z = (const bf16_t*)(p.ws + WS_R1);
    bf16_t* Y = (bf16_t*)(p.ws + WS_Y);
    LAS unsigned char* Ks = lds;
    LAS unsigned char* Vs = lds + 61440;
    const int vcu = __builtin_amdgcn_readfirstlane(*(volatile LAS int*)(lds + LDS_BYTES - 48));
#define BD_PARAMS(u_, b_, hq_, r4_, T0_) int b_, hq_, r4_, T0_; { int bt_ = (u_) >> 3; hq_ = (u_) & 7; if (gridDim.x == 256) { const int v_ = vcu >> 3; bt_ = ((vcu & 7) * 4 + (v_ >> 3)) * 8 + (v_ & 7); hq_ = (u_) >> 8; } \
        b_ = bt_ >> 3; r4_ = 0; T0_ = (bt_ & 7) * 256; }
    u32x4 rk[6], rv[6]; bf16x8 Qn[2][2];
#define BD_FETCH(u_) do { BD_PARAMS(u_, fb, fh, fr, fT); const bf16_t* kh_ = zhead(Z, fb, 8 + fh); const bf16_t* vh_ = zhead(Z, fb, 16 + fh); \
        _Pragma("unroll") for (int k = 0; k < 6; ++k) { int j = fT - 128 + (tid >> 3) + 64 * k; j = j < 0 ? 0 : j; const unsigned so = (unsigned)(j * 64 + 8 * (tid & 7)); \
            rk[k] = *(const u32x4*)(kh_ + so); rv[k] = *(const u32x4*)(vh_ + so); } \
        const bf16_t* qb_ = zhead(Z, fb, fh) + (fT + 32 * wid) * 64; \
        _Pragma("unroll") for (int qt = 0; qt < 2; ++qt) _Pragma("unroll") for (int ks = 0; ks < 2; ++ks) Qn[qt][ks] = *(const bf16x8*)(qb_ + (unsigned)((16 * qt + li) * 64 + 32 * ks + 8 * g)); } while (0)
    const int nunits = NB * 8 * 8;
    if ((int)blockIdx.x < nunits) BD_FETCH((int)blockIdx.x);
    for (int unit = blockIdx.x; unit < nunits; unit += gridDim.x) {
        BD_PARAMS(unit, b, hq, r4, T0);
        __syncthreads();
        {
            LAS unsigned char* lp = Ks + (tid >> 3) * 160 + (tid & 7) * 16;
#pragma unroll
            for (int k = 0; k < 6; ++k) { *(LAS u32x4*)(lp + 64 * 160 * k) = rk[k]; *(LAS u32x4*)(lp + 61440 + 64 * 160 * k) = rv[k]; }
        }
        bf16x8 Qf[2][2];
#pragma unroll
        for (int qt = 0; qt < 2; ++qt)
#pragma unroll
            for (int ks = 0; ks < 2; ++ks) Qf[qt][ks] = Qn[qt][ks];
        __syncthreads();
        if (unit + (int)gridDim.x < nunits) BD_FETCH(unit + (int)gridDim.x);
        const bool early = (T0 == 0);
        LAS const unsigned char* kbase = Ks + (32 * wid + li) * 160 + 16 * g;
        LAS const unsigned char* vbase = Vs + (32 * wid + 4 * g + q4) * 160 + 8 * pp;
        for (int once = 0; once < 1; ++once) {
            f32x4 S[2][10];
            {
                bf16x8 kf[2][2][2];
#pragma unroll
                for (int t = 0; t < 2; ++t)
#pragma unroll
                    for (int ks = 0; ks < 2; ++ks) kf[0][t][ks] = *(LAS const bf16x8*)(kbase + (16 * t) * 160 + 64 * ks);
#pragma unroll
                for (int kb = 0; kb < 5; ++kb) {
                    if (kb + 1 < 5) {
#pragma unroll
                        for (int t = 0; t < 2; ++t)
#pragma unroll
                            for (int ks = 0; ks < 2; ++ks) kf[(kb + 1) & 1][t][ks] = *(LAS const bf16x8*)(kbase + (16 * (2 * (kb + 1) + t)) * 160 + 64 * ks);
                    }
                    __builtin_amdgcn_sched_barrier(0); __builtin_amdgcn_s_setprio(1);
#pragma unroll
                    for (int t = 0; t < 2; ++t)
#pragma unroll
                        for (int qt = 0; qt < 2; ++qt) {
                            f32x4 acc = (f32x4){0.f, 0.f, 0.f, 0.f};
#pragma unroll
                            for (int ks = 0; ks < 2; ++ks) acc = __builtin_amdgcn_mfma_f32_16x16x32_bf16(kf[kb & 1][t][ks], Qf[qt][ks], acc, 0, 0, 0);
                            S[qt][2 * kb + t] = acc;
                        }
__builtin_amdgcn_s_setprio(0); __builtin_amdgcn_sched_barrier(0);
                }
            }
#pragma unroll
            for (int kt = 0; kt < 10; ++kt) {
                if (kt < 2 || kt >= 8 || early) {
#pragma unroll
                    for (int qt = 0; qt < 2; ++qt)
#pragma unroll
                        for (int e = 0; e < 4; ++e) { const int kr = 16 * kt + 4 * g + e - 128, d = 16 * qt + li - kr; if (d < 0 || d > 128 || T0 + 32 * wid + kr < 0) S[qt][kt][e] = -INFINITY; }
                }
            }
            float scl[2], mq[2], lq[2];
            bf16x8 Pf[2][5];
#pragma unroll
            for (int qt = 0; qt < 2; ++qt) {
                float mx = -INFINITY;
#pragma unroll
                for (int kt = 0; kt < 10; ++kt) { mx = max3f(mx, S[qt][kt][0], S[qt][kt][1]); mx = max3f(mx, S[qt][kt][2], S[qt][kt][3]); }
                mx = quad_max(mx);
                float ps = 0.f;
#pragma unroll
                for (int kt = 0; kt < 10; ++kt)
#pragma unroll
                    for (int e = 0; e < 4; ++e) { const float pv = ex2(S[qt][kt][e] - mx); S[qt][kt][e] = pv; ps += pv; }
                lq[qt] = quad_sum(ps); mq[qt] = mx; scl[qt] = 1.0f / lq[qt];
#pragma unroll
                for (int s = 0; s < 5; ++s) {
                    u32x4 w; w.x = pk2(S[qt][2 * s][0], S[qt][2 * s][1]); w.y = pk2(S[qt][2 * s][2], S[qt][2 * s][3]);
                    w.z = pk2(S[qt][2 * s + 1][0], S[qt][2 * s + 1][1]); w.w = pk2(S[qt][2 * s + 1][2], S[qt][2 * s + 1][3]);
                    Pf[qt][s] = __builtin_bit_cast(bf16x8, w);
                }
            }
            f32x4 O[2][4];
#pragma unroll
            for (int qt = 0; qt < 2; ++qt)
#pragma unroll
                for (int dt = 0; dt < 4; ++dt) O[qt][dt] = (f32x4){0.f, 0.f, 0.f, 0.f};
            {
                s16x4 va[2][4][2];
#pragma unroll
                for (int dt = 0; dt < 4; ++dt) { va[0][dt][0] = vtr(vbase + 32 * dt); va[0][dt][1] = vtr(vbase + 16 * 160 + 32 * dt); }
#pragma unroll
                for (int s = 0; s < 5; ++s) {
                    if (s + 1 < 5) {
#pragma unroll
                        for (int dt = 0; dt < 4; ++dt) { va[(s + 1) & 1][dt][0] = vtr(vbase + (32 * (s + 1)) * 160 + 32 * dt); va[(s + 1) & 1][dt][1] = vtr(vbase + (32 * (s + 1) + 16) * 160 + 32 * dt); }
                    }
                    __builtin_amdgcn_sched_barrier(0); __builtin_amdgcn_s_setprio(1);
#pragma unroll
                    for (int dt = 0; dt < 4; ++dt) {
                        const s16x4 a1 = va[s & 1][dt][0], a2 = va[s & 1][dt][1];
                        const bf16x8 vf = (bf16x8){a1[0], a1[1], a1[2], a1[3], a2[0], a2[1], a2[2], a2[3]};
#pragma unroll
                        for (int qt = 0; qt < 2; ++qt) O[qt][dt] = __builtin_amdgcn_mfma_f32_16x16x32_bf16(vf, Pf[qt][s], O[qt][dt], 0, 0, 0);
                    }
__builtin_amdgcn_s_setprio(0); __builtin_amdgcn_sched_barrier(0);
                }
            }
#pragma unroll
                for (int qt = 0; qt < 2; ++qt) {
                    const int tl = 32 * wid + 16 * qt + li;
                    const size_t trow = (size_t)b * SEQ + T0 + tl;
                    const float l16 = ((const float*)(p.ws + WS_L16))[trow * 8 + hq], m16 = ((const float*)(p.ws + WS_M16))[trow * 8 + hq];
                    const float l4 = ((const float*)(p.ws + WS_L4))[trow * 8 + hq], m4 = ((const float*)(p.ws + WS_M4))[trow * 8 + hq];
                    const bf16_t* s16 = (const bf16_t*)(p.ws + WS_P16) + trow * 512 + 64 * hq + 4 * g;
                    const bf16_t* s4 = (const bf16_t*)(p.ws + WS_P4) + trow * 512 + 64 * hq + 4 * g;
                    const float mn = max3f(m16, m4, mq[qt]);
                    const float f16 = ex2(m16 - mn) * l16, f4 = ex2(m4 - mn) * l4, f1 = ex2(mq[qt] - mn);
                    const float inv = 1.0f / (f16 + f4 + lq[qt] * f1);
                    bf16_t* dst = Y + trow * DM + 64 * hq + 4 * g;
#pragma unroll
                    for (int dt = 0; dt < 4; ++dt) {
                        const u32x2 pa = *(const u32x2*)(s16 + 16 * dt), pb = *(const u32x2*)(s4 + 16 * dt);
                        f32x4 o = O[qt][dt] * f1;
                        o[0] += __uint_as_float(pa.x << 16) * f16 + __uint_as_float(pb.x << 16) * f4; o[1] += __uint_as_float(pa.x & 0xffff0000u) * f16 + __uint_as_float(pb.x & 0xffff0000u) * f4;
                        o[2] += __uint_as_float(pa.y << 16) * f16 + __uint_as_float(pb.y << 16) * f4; o[3] += __uint_as_float(pa.y & 0xffff0000u) * f16 + __uint_as_float(pb.y & 0xffff0000u) * f4;
                        o = o * inv;
                        u32x2 w; w.x = pk2(o[0], o[1]); w.y = pk2(o[2], o[3]);
                        *(u32x2*)(dst + 16 * dt) = w;
                    }
                }
        }
    }
#undef BD_PARAMS
#undef BD_FETCH
    __syncthreads();
}

struct NoFn { __device__ __forceinline__ f32x4 init(int) const { return (f32x4){0.f, 0.f, 0.f, 0.f}; } __device__ __forceinline__ f32x4 apply(f32x4 s, int, int) const { return s; } };

__device__ __forceinline__ void xattn_phase(const Params& p, LAS unsigned char* lds, int layer) {
    int tid_l = threadIdx.x; asm volatile("" : "+v"(tid_l)); const int tid = tid_l, lane = tid & 63, wid = __builtin_amdgcn_readfirstlane(tid >> 6), li = lane & 15, g = lane >> 4;
    const bf16_t* Q = (const bf16_t*)(p.ws + WS_R1);
    const bf16_t* KV = (const bf16_t*)(p.ws + WS_KV + (size_t)layer * 32 * MiB);
    bf16_t* Y = (bf16_t*)(p.ws + WS_Y);
    LAS unsigned char* T = lds;
    const int nunits = NB * 4 * 8;
    const bool xmap = (gridDim.x == 256);
    const int vcu = __builtin_amdgcn_readfirstlane(*(volatile LAS int*)(lds + LDS_BYTES - 48));
    for (int unit = blockIdx.x; unit < nunits; unit += gridDim.x) {
        int bh = unit >> 3, qb = unit & 7;
        if (xmap) { const int x = vcu & 7, v = vcu >> 3, i = unit >> 8; bh = x * 16 + 4 * i + (v >> 3); qb = v & 7; }
        const int b = bh >> 2, h = bh & 3;
        const bf16_t* Qb = Q + ((size_t)b * SEQ + qb * 256 + 32 * wid) * DM + 256 * h;
        bf16_t* Yb = Y + ((size_t)b * SEQ + qb * 256 + 32 * wid) * DM + 256 * h;
        const unsigned qoff = (unsigned)li * DM + 8 * g;
        const bf16_t* kvb = KV + (size_t)b * MEMLEN * 2 * DM + 256 * h;
        u32x4 rr[16];
#define XA_LOAD() do { _Pragma("unroll") for (int i = 0; i < 16; ++i) { rr[i] = *(const u32x4*)gp; gp += 16 * 2 * DM; asm volatile("" : "+v"(gp)); } } while (0)
#define XA_STORE() do { _Pragma("unroll") for (int i = 0; i < 16; ++i) { *(LAS u32x4*)lp = rr[i]; lp += 16 * 544; asm volatile("" : "+v"(lp)); } } while (0)
        const bf16_t* gp = kvb + (unsigned)((tid >> 5) * 2 * DM + 8 * (tid & 31));
        LAS unsigned char* lp = T + (tid >> 5) * 544 + (tid & 31) * 16;
        asm volatile("" : "+v"(gp)); asm volatile("" : "+v"(lp));
        XA_LOAD();
        __syncthreads();
        XA_STORE();
        __syncthreads();
        f32x4 S[2][16];
#pragma unroll
        for (int qt = 0; qt < 2; ++qt)
#pragma unroll
            for (int kt = 0; kt < 16; ++kt) S[qt][kt] = (f32x4){0.f, 0.f, 0.f, 0.f};
        LAS const unsigned char* kbase = T + li * 544 + 16 * g;
#pragma unroll
        for (int kq = 0; kq < 4; ++kq) {
            bf16x8 Qf[2][2];
#pragma unroll
            for (int qt = 0; qt < 2; ++qt)
#pragma unroll
                for (int j = 0; j < 2; ++j) Qf[qt][j] = *(const bf16x8*)(Qb + (qoff + (unsigned)(16 * qt * DM + 32 * (2 * kq + j))));
            LAS const unsigned char* kp = kbase + 128 * kq;
            asm volatile("" : "+v"(kp));
            bf16x8 kf[2][2];
#pragma unroll
            for (int j = 0; j < 2; ++j) kf[0][j] = *(LAS const bf16x8*)(kp + 64 * j);
#pragma unroll
            for (int kt = 0; kt < 16; ++kt) {
                if (kt + 1 < 16) {
                    kp += 16 * 544; asm volatile("" : "+v"(kp));
#pragma unroll
                    for (int j = 0; j < 2; ++j) kf[(kt + 1) & 1][j] = *(LAS const bf16x8*)(kp + 64 * j);
                }
                __builtin_amdgcn_sched_barrier(0); __builtin_amdgcn_s_setprio(1);
#pragma unroll
                for (int j = 0; j < 2; ++j)
#pragma unroll
                    for (int qt = 0; qt < 2; ++qt) S[qt][kt] = __builtin_amdgcn_mfma_f32_16x16x32_bf16(kf[kt & 1][j], Qf[qt][j], S[qt][kt], 0, 0, 0);
__builtin_amdgcn_s_setprio(0); __builtin_amdgcn_sched_barrier(0);
            }
        }
        float linv[2];
        bf16x8 Pf[2][8];
#pragma unroll
        for (int qt = 0; qt < 2; ++qt) {
            float mx = -INFINITY;
#pragma unroll
            for (int kt = 0; kt < 16; ++kt) { mx = max3f(mx, S[qt][kt][0], S[qt][kt][1]); mx = max3f(mx, S[qt][kt][2], S[qt][kt][3]); }
            mx = quad_max(mx);
            float ps = 0.f;
#pragma unroll
            for (int kt = 0; kt < 16; ++kt)
#pragma unroll
                for (int e = 0; e < 4; ++e) { const float pv = ex2(S[qt][kt][e] - mx); S[qt][kt][e] = pv; ps += pv; }
            linv[qt] = 1.0f / quad_sum(ps);
#pragma unroll
            for (int s = 0; s < 8; ++s) {
                u32x4 w; w.x = pk2(S[qt][2 * s][0], S[qt][2 * s][1]); w.y = pk2(S[qt][2 * s][2], S[qt][2 * s][3]);
                w.z = pk2(S[qt][2 * s + 1][0], S[qt][2 * s + 1][1]); w.w = pk2(S[qt][2 * s + 1][2], S[qt][2 * s + 1][3]);
                Pf[qt][s] = __builtin_bit_cast(bf16x8, w);
            }
            __builtin_amdgcn_sched_barrier(0);
        }
        gp = kvb + (unsigned)((tid >> 5) * 2 * DM + 8 * (tid & 31) + DM); lp = T + (tid >> 5) * 544 + (tid & 31) * 16;
        asm volatile("" : "+v"(gp)); asm volatile("" : "+v"(lp));
        XA_LOAD();
        __syncthreads();
        XA_STORE();
        __syncthreads();
#undef XA_LOAD
#undef XA_STORE
        const int q4 = li >> 2, pp = li & 3;
        LAS const unsigned char* vbase = T + (4 * g + q4) * 544 + 8 * pp;
#pragma unroll
        for (int dh = 0; dh < 2; ++dh) {
            f32x4 O[2][8];
#pragma unroll
            for (int qt = 0; qt < 2; ++qt)
#pragma unroll
                for (int dt = 0; dt < 8; ++dt) O[qt][dt] = (f32x4){0.f, 0.f, 0.f, 0.f};
            s16x4 va[2][4][2];
            LAS const unsigned char* vp = vbase + 32 * (8 * dh);
            asm volatile("" : "+v"(vp));
#pragma unroll
            for (int j = 0; j < 4; ++j) { va[0][j][0] = vtr(vp + 32 * j); va[0][j][1] = vtr(vp + 16 * 544 + 32 * j); }
#pragma unroll
            for (int bi = 0; bi < 16; ++bi) {
                if (bi + 1 < 16) {
                    if (((bi + 1) & 1) == 0) { vp += 32 * 544; asm volatile("" : "+v"(vp)); }
                    const int d1 = 4 * ((bi + 1) & 1);
#pragma unroll
                    for (int j = 0; j < 4; ++j) { va[(bi + 1) & 1][j][0] = vtr(vp + 32 * (d1 + j)); va[(bi + 1) & 1][j][1] = vtr(vp + 16 * 544 + 32 * (d1 + j)); }
                }
                __builtin_amdgcn_sched_barrier(0); __builtin_amdgcn_s_setprio(1);
                const int s = bi >> 1, d0 = 4 * (bi & 1);
#pragma unroll
                for (int j = 0; j < 4; ++j) {
                    const s16x4 a1 = va[bi & 1][j][0], a2 = va[bi & 1][j][1];
                    const bf16x8 vf = (bf16x8){a1[0], a1[1], a1[2], a1[3], a2[0], a2[1], a2[2], a2[3]};
#pragma unroll
                    for (int qt = 0; qt < 2; ++qt) O[qt][d0 + j] = __builtin_amdgcn_mfma_f32_16x16x32_bf16(vf, Pf[qt][s], O[qt][d0 + j], 0, 0, 0);
                }
__builtin_amdgcn_s_setprio(0); __builtin_amdgcn_sched_barrier(0);
            }
#pragma unroll
            for (int qt = 0; qt < 2; ++qt) {
                bf16_t* dst = Yb + ((unsigned)li * DM + (unsigned)(16 * qt * DM + 128 * dh) + 4 * g);
#pragma unroll
                for (int dt = 0; dt < 8; ++dt) { const f32x4 o = O[qt][dt] * linv[qt]; u32x2 w; w.x = pk2(o[0], o[1]); w.y = pk2(o[2], o[3]); *(u32x2*)(dst + 16 * dt) = w; }
            }
        }
    }
    __syncthreads();
}

__device__ __forceinline__ void final_phase(const Params& p) {
    int tid_l = threadIdx.x; asm volatile("" : "+v"(tid_l)); const int tid = tid_l, lane = tid & 63, wid = tid >> 6;
    const float* ssq = (const float*)(p.ws + WS_SSQ);
    const bf16_t* hb = (const bf16_t*)(p.ws + WS_HB);
    const int gw = blockIdx.x * 8 + wid, NGW = gridDim.x * 8;
    for (int row = gw; row < MTOK; row += NGW) {
        const float rs = pg8::row_rstd(ssq, row);
#pragma unroll
        for (int i = 0; i < 2; ++i) {
            const int c0 = 8 * (lane + 64 * i);
            const u32x4 bw = *(const u32x4*)(hb + (size_t)row * DM + c0);
            const f32x4 g0 = *(const f32x4*)(p.in[25] + c0), g1 = *(const f32x4*)(p.in[25] + c0 + 4);
            f32x4 o0, o1;
            o0[0] = __uint_as_float(bw.x << 16) * rs * g0[0]; o0[1] = __uint_as_float(bw.x & 0xffff0000u) * rs * g0[1];
            o0[2] = __uint_as_float(bw.y << 16) * rs * g0[2]; o0[3] = __uint_as_float(bw.y & 0xffff0000u) * rs * g0[3];
            o1[0] = __uint_as_float(bw.z << 16) * rs * g1[0]; o1[1] = __uint_as_float(bw.z & 0xffff0000u) * rs * g1[1];
            o1[2] = __uint_as_float(bw.w << 16) * rs * g1[2]; o1[3] = __uint_as_float(bw.w & 0xffff0000u) * rs * g1[3];
            f32x4* dst = (f32x4*)(p.out + (size_t)row * DM + c0);
            __builtin_nontemporal_store(o0, dst); __builtin_nontemporal_store(o1, dst + 1);
        }
    }
}

#define XB_TMO      128
#define XB_XCNT(j)  (256  + 64 * (j))
#define XB_XSUB(j)  (1280 + 64 * (j))
#define XB_XGEN(j)  (2304 + 64 * (j))
#define XB_TOP      3328
#define XB_TOPGEN   3392
#define XCD_BAR_WORDS 3456
#define XB_SPIN_CAP (1u << 18)

__device__ __forceinline__ unsigned xb_ld(unsigned* p)              { return __hip_atomic_load(p, __ATOMIC_RELAXED, __HIP_MEMORY_SCOPE_AGENT); }
__device__ __forceinline__ unsigned xb_add(unsigned* p, unsigned v) { return __hip_atomic_fetch_add(p, v, __ATOMIC_RELAXED, __HIP_MEMORY_SCOPE_AGENT); }
__device__ __forceinline__ unsigned xb_xcc_id() { return (unsigned)__builtin_amdgcn_s_getreg((3 << 11) | 20) & 0xFu; }
#define XB_SPIN(cond, bar) do { unsigned _sp = 0; while (cond) { __builtin_amdgcn_s_sleep(1); \
    if ((++_sp & 255u) == 0u) { if (xb_ld(&(bar)[XB_TMO])) break; if (_sp > XB_SPIN_CAP) { atomicAdd(&(bar)[XB_TMO], 1u); break; } } } } while (0)

struct XcdBarrier {
    unsigned* bar; unsigned x;
    volatile LAS unsigned* st;
};

__device__ __forceinline__ XcdBarrier xcd_barrier_post(unsigned* bar, volatile LAS unsigned* st) {
    XcdBarrier b; b.bar = bar; b.x = xb_xcc_id(); b.st = st;
    if (threadIdx.x == 0) (void)xb_add(&bar[XB_XCNT(b.x)], 1u);
    return b;
}
__device__ __forceinline__ void xcd_barrier_complete(unsigned* bar, unsigned x, unsigned& nloc, unsigned& nx) {
    const unsigned G = gridDim.x * gridDim.y * gridDim.z;
    unsigned sum, cnt, mine, sp = 0u;
    for (;;) {
        sum = 0u; cnt = 0u; mine = 0u;
#pragma unroll
        for (unsigned j = 0; j < 16; ++j) { const unsigned c = xb_ld(&bar[XB_XCNT(j)]); sum += c; cnt += (c > 0u) ? 1u : 0u; mine = (j == x) ? c : mine; }
        if (sum == G) break;
        __builtin_amdgcn_s_sleep(1);
        if ((++sp & 255u) == 0u) { if (xb_ld(&bar[XB_TMO])) break; if (sp > XB_SPIN_CAP) { atomicAdd(&bar[XB_TMO], 1u); break; } }
    }
    nloc = mine > 0u ? mine : 1u; nx = cnt > 0u ? cnt : 1u;
}

__device__ __forceinline__ void xcd_barrier(const XcdBarrier& b) {
    asm volatile("s_waitcnt vmcnt(0)" ::: "memory");
    __syncthreads();
    if (threadIdx.x == 0) {
        unsigned* bar = b.bar;
        __builtin_amdgcn_s_waitcnt(0);
        unsigned nloc = b.st[0], nx = b.st[1];
        if (nloc == 0u) { xcd_barrier_complete(bar, b.x, nloc, nx); b.st[0] = nloc; b.st[1] = nx; }
        const unsigned old = xb_add(&bar[XB_XSUB(b.x)], 1u);
        const unsigned gen = old / nloc;
        if (old + 1u == (gen + 1u) * nloc) {
            __builtin_amdgcn_fence(__ATOMIC_RELEASE, "agent");
            asm volatile("s_waitcnt vmcnt(0)" ::: "memory");
            const unsigned og = xb_add(&bar[XB_TOP], 1u);
            const unsigned tg = og / nx;
            if (og + 1u == (tg + 1u) * nx) xb_add(&bar[XB_TOPGEN], 1u);
            else XB_SPIN(xb_ld(&bar[XB_TOPGEN]) == tg, bar);
            __builtin_amdgcn_fence(__ATOMIC_ACQUIRE, "agent");
            xb_add(&bar[XB_XGEN(b.x)], 1u);
            asm volatile("s_waitcnt vmcnt(0)" ::: "memory");
        } else {
            XB_SPIN(xb_ld(&bar[XB_XGEN(b.x)]) == gen, bar);
            __builtin_amdgcn_fence(__ATOMIC_ACQUIRE, "agent");
            asm volatile("s_waitcnt vmcnt(0)" ::: "memory");
        }
    }
    __syncthreads();
}

template <class Epi>
__device__ __forceinline__ void run_gemm(LAS unsigned char* lds, const bf16_t* A, const bf16_t* Bt, int M, int N, int K, const Epi& E) {
    pg8::Gemm g{A, Bt, M, N, K};
    const int vcu = __builtin_amdgcn_readfirstlane(*(volatile LAS int*)(lds + LDS_BYTES - 48));
    pg8::StaticOrder S; S.init(M, N, (int)gridDim.x, vcu);
    pg8::gemm_phase<Epi, pg8::StaticOrder, true, true>(lds, g, S, E);
    __syncthreads();
}

__global__ void __launch_bounds__(512, 2) mega_fwd(Params p) {
    extern __shared__ __attribute__((aligned(16))) unsigned char lds_raw[];
    LAS unsigned char* lds = (LAS unsigned char*)lds_raw;
    cg::grid_group grid = cg::this_grid();
    volatile LAS unsigned* bst = (volatile LAS unsigned*)(lds + LDS_BYTES - 64);
    if (threadIdx.x < 2) bst[threadIdx.x] = 0u;
    __syncthreads();
    const XcdBarrier xbar = xcd_barrier_post((unsigned*)(p.ws + WS_BAR), bst);
    volatile LAS int* vslot = (volatile LAS int*)(lds + LDS_BYTES - 48);
    unsigned* census = (unsigned*)(p.ws + WS_BAR + 16384);
    if (threadIdx.x == 0) { const unsigned mx_ = hw_xcc_id() & 7u; vslot[1] = (int)mx_; vslot[2] = (int)__hip_atomic_fetch_add(census + 64 * mx_, 1u, __ATOMIC_RELAXED, __HIP_MEMORY_SCOPE_AGENT); }
    unsigned char* ws = p.ws;
    bf16_t* hb = (bf16_t*)(ws + WS_HB);
    float* ssq = (float*)(ws + WS_SSQ);
    bf16_t* R1 = (bf16_t*)(ws + WS_R1);
    bf16_t* Y = (bf16_t*)(ws + WS_Y);

    p0_prologue(p, lds);
#if PROBE_DUP == 4
    p0_prologue(p, lds);
#endif
    if (p.out == nullptr) grid.sync();
    xcd_barrier(xbar);
    if (threadIdx.x == 0) {
        unsigned v = 0; const unsigned my_x = (unsigned)vslot[1], my_rank = (unsigned)vslot[2];
#pragma unroll 1
        for (unsigned x = 0; x < 8; ++x) { const unsigned n = __hip_atomic_load(census + 64 * x, __ATOMIC_RELAXED, __HIP_MEMORY_SCOPE_AGENT); v += (n < my_rank ? n : my_rank) + ((x < my_x && n > my_rank) ? 1u : 0u); }
        vslot[0] = (int)v;
    }
    __syncthreads();
    fox_cumsum(p);
    __syncthreads();
    for (int l = 0; l < 2; ++l) {
        pg8::EpiScale<0> E{(bf16_t*)(ws + WS_KV + (size_t)l * 32 * MiB), 2 * DM, nullptr};
        run_gemm(lds, (const bf16_t*)(ws + WS_MEMN + (size_t)l * 16 * MiB), (const bf16_t*)(ws + WS_WKV + (size_t)l * 4 * MiB), MMEM, 2 * DM, DM, E);
    }
    for (int layer = 0; layer < 2; ++layer) {
        if (layer == 0) {
            pg8::EpiScale<0> E{R1, ABN, ssq};
            run_gemm(lds, hb, (const bf16_t*)(ws + WS_WIN0), MTOK, ABN, DM, E);
            xcd_barrier(xbar);
            lru_phase(p, lds);
#if PROBE_DUP == 1
            lru_phase(p, lds);
#endif
            fox_phase(p, lds);
#if PROBE_DUP == 2
            fox_phase(p, lds);
#endif
            xcd_barrier(xbar);
            pg8::EpiResid E2{hb, ssq};
            run_gemm(lds, Y, (const bf16_t*)(ws + WS_WOUT0), MTOK, DM, DM, E2);
        } else {
            pg8::EpiRope E{R1, ssq, (const f32x2*)(ws + WS_ROPE)};
            run_gemm(lds, hb, (const bf16_t*)(ws + WS_WIN1), MTOK, CDN, DM, E);
#if PROBE_DUP == 8
            run_gemm(lds, hb, (const bf16_t*)(ws + WS_WIN1), MTOK, CDN, DM, E);
#endif
            xcd_barrier(xbar);
            d16_phase(p, lds);
            d4_phase(p, lds);
            swa_phase(p, lds);
#if PROBE_DUP == 14
            d16_phase(p, lds);
            d4_phase(p, lds);
            swa_phase(p, lds);
#endif
            xcd_barrier(xbar);
#if PROBE_DUP == 13
            swa_phase(p, lds);
#endif
            band_phase(p, lds);
#if PROBE_DUP == 3
            band_phase(p, lds, 1);
#endif
            xcd_barrier(xbar);
            pg8::EpiResid E2{hb, ssq};
            run_gemm(lds, Y, (const bf16_t*)(ws + WS_WOUT1), MTOK, DM, DM, E2);
        }
        xcd_barrier(xbar);
        {
            pg8::EpiScale<0> E{R1, DM, ssq};
            run_gemm(lds, hb, (const bf16_t*)(ws + WS_WQ + (size_t)layer * 2 * MiB), MTOK, DM, DM, E);
#if PROBE_DUP == 7
            run_gemm(lds, hb, (const bf16_t*)(ws + WS_WQ + (size_t)layer * 2 * MiB), MTOK, DM, DM, E);
#endif
            xcd_barrier(xbar);
            xattn_phase(p, lds, layer);
#if PROBE_DUP == 5
            xattn_phase(p, lds, layer);
#endif
            xcd_barrier(xbar);
            pg8::EpiResid E2{hb, ssq};
            run_gemm(lds, Y, (const bf16_t*)(ws + WS_WO + (size_t)layer * 2 * MiB), MTOK, DM, DM, E2);
        }
        xcd_barrier(xbar);
        {
            pg8::EpiScale<1> E{R1, DFF, ssq};
            run_gemm(lds, hb, (const bf16_t*)(ws + WS_WUP + (size_t)layer * 8 * MiB), MTOK, DFF, DM, E);
#if PROBE_DUP == 6
            run_gemm(lds, hb, (const bf16_t*)(ws + WS_WUP + (size_t)layer * 8 * MiB), MTOK, DFF, DM, E);
#endif
            xcd_barrier(xbar);
            pg8::EpiResid E2{hb, ssq};
#if PROBE_DUP == 9
            { pg8::EpiResid E3{Y, (float*)(ws + WS_CS)}; run_gemm(lds, R1, (const bf16_t*)(ws + WS_WDN + (size_t)layer * 8 * MiB), MTOK, DM, DFF, E3); }
#endif
            run_gemm(lds, R1, (const bf16_t*)(ws + WS_WDN + (size_t)layer * 8 * MiB), MTOK, DM, DFF, E2);
        }
        xcd_barrier(xbar);
    }
#if PROBE_DUP == 10
    for (int i = 0; i < 10; ++i) xcd_barrier(xbar);
#endif
    final_phase(p);
#if PROBE_DUP == 11
    if (threadIdx.x == 0 && (hw_xcc_id() & 7u) != (blockIdx.x & 7u)) p.out[blockIdx.x] = __builtin_nanf("");
#endif
}

extern "C" void kernel_launch(void* const* d_in, const int* in_sizes, int n_in, void* d_out, int out_size, void* d_ws, size_t ws_size, hipStream_t stream) {
    static int grid = 0;
    if (grid == 0) {
        if (n_in != 26 || out_size != MTOK * DM || ws_size < WS_END) { fprintf(stderr, "kernel_launch: unexpected shapes (n_in %d out %d ws %zu)\n", n_in, out_size, ws_size); grid = -1; return; }
        int dev = 0, cus = 0, per_cu = 0;
        hipGetDevice(&dev);
        hipDeviceGetAttribute(&cus, hipDeviceAttributeMultiprocessorCount, dev);
        if (hipFuncSetAttribute((const void*)mega_fwd, hipFuncAttributeMaxDynamicSharedMemorySize, LDS_BYTES) != hipSuccess) { fprintf(stderr, "kernel_launch: hipFuncSetAttribute failed\n"); grid = -1; return; }
        if (hipOccupancyMaxActiveBlocksPerMultiprocessor(&per_cu, (const void*)mega_fwd, 512, LDS_BYTES) != hipSuccess || per_cu < 1) { fprintf(stderr, "kernel_launch: occupancy query says %d\n", per_cu); per_cu = 1; }
        (void)hipGetLastError();
        grid = cus * per_cu;
    }
    if (grid < 0) return;
    if (hipMemsetAsync((char*)d_ws + WS_BAR, 0, WS_BAR_BYTES, stream) != hipSuccess) { fprintf(stderr, "kernel_launch: memset failed\n"); return; }
    Params prm{};
    for (int i = 0; i < 26; ++i) prm.in[i] = (const float*)d_in[i];
    prm.out = (float*)d_out; prm.ws = (unsigned char*)d_ws;
    void* args[] = {&prm};
    hipError_t e = hipLaunchCooperativeKernel((const void*)mega_fwd, dim3(grid), dim3(512), args, LDS_BYTES, stream);
    if (e != hipSuccess) fprintf(stderr, "cooperative launch failed: %s (grid %d)\n", hipGetErrorString(e), grid);
}
```

```cpp
#include <hip/hip_runtime.h>
#include <hip/hip_cooperative_groups.h>
#include <cstdio>
#include <cstdint>
namespace cg = cooperative_groups;
#ifndef PROBE_DRY
#define PROBE_DRY 0
#endif
#ifndef PROBE_DUP
#define PROBE_DUP 0
#endif

#define LAS __attribute__((address_space(3)))
typedef unsigned short bf16_t;
typedef short bf16x8 __attribute__((ext_vector_type(8)));
typedef short s16x4 __attribute__((ext_vector_type(4)));
typedef float f32x4 __attribute__((ext_vector_type(4)));
typedef float f32x2 __attribute__((ext_vector_type(2)));
typedef unsigned u32x4 __attribute__((ext_vector_type(4)));
typedef unsigned u32x2 __attribute__((ext_vector_type(2)));

constexpr int DM = 1024, NB = 32, SEQ = 2048, MTOK = NB * SEQ, MEMLEN = 256, MMEM = NB * MEMLEN;
constexpr int ABN = 2560, AB_IN = 2568, CDN = 2304, DFF = 4096;
constexpr float EPS = 1e-6f;
constexpr float LOG2E = 1.4426950408889634f;

typedef __bf16 bf16x2_t __attribute__((ext_vector_type(2)));
__device__ __forceinline__ unsigned pk2(float lo, float hi) { f32x2 v = {lo, hi}; bf16x2_t b = __builtin_convertvector(v, bf16x2_t); return __builtin_bit_cast(unsigned, b); }
__device__ __forceinline__ unsigned f2bf(float f) { return pk2(f, 0.f) & 0xffffu; }
__device__ __forceinline__ float bf2f(unsigned b) { return __uint_as_float(b << 16); }
__device__ __forceinline__ float wave_sum(float v) {
#pragma unroll
    for (int o = 32; o >= 1; o >>= 1) v += __shfl_xor(v, o);
    return v;
}
__device__ __forceinline__ float ex2(float x) { return __builtin_amdgcn_exp2f(x); }
__device__ __forceinline__ float max2f(float x, float y) { return __builtin_amdgcn_fmed3f(x, y, INFINITY); }
__device__ __forceinline__ float max3f(float x, float y, float z) { return max2f(max2f(x, y), z); }
__device__ __forceinline__ float xor16_max(float x) { const auto rr = __builtin_amdgcn_permlane16_swap(__float_as_uint(x), __float_as_uint(x), false, false); return max2f(__uint_as_float(rr[0]), __uint_as_float(rr[1])); }
__device__ __forceinline__ float xor32_max(float x) { const auto rr = __builtin_amdgcn_permlane32_swap(__float_as_uint(x), __float_as_uint(x), false, false); return max2f(__uint_as_float(rr[0]), __uint_as_float(rr[1])); }
__device__ __forceinline__ float xor16_sum(float x) { const auto rr = __builtin_amdgcn_permlane16_swap(__float_as_uint(x), __float_as_uint(x), false, false); return __uint_as_float(rr[0]) + __uint_as_float(rr[1]); }
__device__ __forceinline__ float xor32_sum(float x) { const auto rr = __builtin_amdgcn_permlane32_swap(__float_as_uint(x), __float_as_uint(x), false, false); return __uint_as_float(rr[0]) + __uint_as_float(rr[1]); }
__device__ __forceinline__ float quad_max(float x) { return xor32_max(xor16_max(x)); }
__device__ __forceinline__ float quad_sum(float x) { return xor32_sum(xor16_sum(x)); }
namespace pg8 {
#define PG8_LAS __attribute__((address_space(3)))
typedef unsigned short bf16_t;
typedef short bf16x8 __attribute__((ext_vector_type(8)));
typedef float f32x4 __attribute__((ext_vector_type(4)));
typedef unsigned u32x4 __attribute__((ext_vector_type(4)));
constexpr int BM = 256, BK = 64, HALF = 128, HTB = HALF * BK * 2  , STAGE_BYTES = 8 * HTB, NXCD = 8, WGM = 8;

__host__ __device__ __forceinline__ int lds_byte(int r, int c) { const int st = (r >> 4) * 2 + (c >> 5), rr = r & 15, cc = c & 31, ob = rr * 64 + cc * 2; return st * 1024 + (ob ^ (((ob >> 9) & 1) << 5)); }
__host__ __device__ __forceinline__ void stage_rc(int b, int& R, int& C) { const int st = b / 1024, sb = b % 1024, swz = sb ^ (((sb >> 9) & 1) << 5); R = (st >> 1) * 16 + swz / 64; C = (st & 1) * 32 + (swz % 64) / 2; }
__host__ __device__ __forceinline__ int perm32(int rho) { const int n = rho >> 4, i = rho & 15; return 8 * (i >> 2) + 4 * n + (i & 3); }

struct Unit { int pm, pn; };
struct Gemm { const bf16_t* A; const bf16_t* Bt; int M, N, K; };

struct StaticOrder {
    int nM, nN, nwg, G, c;
    __host__ __device__ void init(int M, int N, int G_, int c_) { nM = M / BM; nN = N / BM; nwg = nM * nN; G = G_; c = c_; }
    __host__ __device__ bool next(int i, Unit& u) const {
        const long L = (long)i * G + c; if (L >= nwg) return false;
        int wgid = (int)L; { const int q = nwg / NXCD, r = nwg % NXCD, xcd = wgid % NXCD, off = wgid / NXCD; wgid = (xcd < r ? xcd * (q + 1) : r * (q + 1) + (xcd - r) * q) + off; }
        const int nig = WGM * nN, gid = wgid / nig, fm = gid * WGM, gsz = (nM - fm) < WGM ? (nM - fm) : WGM;
        u.pm = fm + ((wgid % nig) % gsz); u.pn = (wgid % nig) / gsz; return true;
    }
    __device__ __forceinline__ void a_ready(const Unit&) const {}
    __device__ __forceinline__ void done(const Unit&) const {}
};


__device__ __forceinline__ float row_rstd(const float* ssq, int row) {
    const f32x4* s = (const f32x4*)(ssq + (size_t)row * 16);
    const f32x4 a = s[0], b = s[1], c = s[2], d = s[3];
    const float t = ((a[0] + a[1]) + (a[2] + a[3])) + ((b[0] + b[1]) + (b[2] + b[3])) + ((c[0] + c[1]) + (c[2] + c[3])) + ((d[0] + d[1]) + (d[2] + d[3]));
    return 1.0f / sqrtf(t * (1.0f / 1024.0f) + EPS);
}
__device__ __forceinline__ void rstd8(const float* ssq, int row0, int fq, float (&rs)[8]) {
    f32x4 q[8];
#pragma unroll
    for (int i = 0; i < 8; ++i) q[i] = *(const f32x4*)(ssq + (size_t)(row0 + (i >> 2) * HALF + (i & 3) * 16) * 16 + 4 * fq);
    __builtin_amdgcn_sched_barrier(0);
#pragma unroll
    for (int i = 0; i < 8; ++i) { const float t = quad_sum((q[i][0] + q[i][1]) + (q[i][2] + q[i][3])); rs[i] = __builtin_amdgcn_rsqf(t * (1.0f / 1024.0f) + EPS); }
}
template <int ACT> struct EpiScale {
    static constexpr bool PERM = true, AFTER_DRAIN = false;
    bf16_t* O; int ldc; const float* ssq;
    __device__ __forceinline__ void operator()(const f32x4 (&acc)[2][2][4][2], const Unit& u, int wr, int wc, int fr, int fq) const {
        const int row0 = u.pm * BM + wr * 64 + fr, col0 = u.pn * BM + wc * 32 + 8 * fq;
        float rs[8];
        if (ssq) rstd8(ssq, row0, fq, rs);
        else {
#pragma unroll
            for (int i = 0; i < 8; ++i) rs[i] = 1.0f;
        }
#pragma unroll
        for (int ai = 0; ai < 2; ++ai)
#pragma unroll
            for (int m = 0; m < 4; ++m) {
                const int row = row0 + ai * HALF + m * 16;
                const float r1 = rs[ai * 4 + m];
                bf16_t* rowp = O + (size_t)row * ldc + col0;
#pragma unroll
                for (int bj = 0; bj < 2; ++bj) {
                    f32x4 v0 = acc[ai][bj][m][0] * r1, v1 = acc[ai][bj][m][1] * r1;
                    if (ACT == 1) {
#pragma unroll
                        for (int e = 0; e < 4; ++e) { float a = fmaxf(v0[e], 0.f), b = fmaxf(v1[e], 0.f); v0[e] = a * a; v1[e] = b * b; }
                    }
                    u32x4 w; w.x = pk2(v0[0], v0[1]); w.y = pk2(v0[2], v0[3]); w.z = pk2(v1[0], v1[1]); w.w = pk2(v1[2], v1[3]);
                    *(u32x4*)(rowp + bj * HALF) = w;
                }
            }
    }
};
struct EpiResid {
    static constexpr bool PERM = true, AFTER_DRAIN = false;
    bf16_t* hb; float* ssq;
    __device__ __forceinline__ void operator()(const f32x4 (&acc)[2][2][4][2], const Unit& u, int wr, int wc, int fr, int fq) const {
        const int row0 = u.pm * BM + wr * 64 + fr, col0 = u.pn * BM + wc * 32 + 8 * fq;
        u32x4 bw[8][2];
#pragma unroll
        for (int i = 0; i < 8; ++i)
#pragma unroll
            for (int bj = 0; bj < 2; ++bj) bw[i][bj] = *(const u32x4*)(hb + (size_t)(row0 + (i >> 2) * HALF + (i & 3) * 16) * DM + col0 + bj * HALF);
        __builtin_amdgcn_sched_barrier(0);
#pragma unroll
        for (int ai = 0; ai < 2; ++ai)
#pragma unroll
            for (int m = 0; m < 4; ++m) {
                const int row = row0 + ai * HALF + m * 16;
                const size_t off = (size_t)row * DM + col0;
                float sq = 0.f;
#pragma unroll
                for (int bj = 0; bj < 2; ++bj) {
                    const u32x4 b4 = bw[ai * 4 + m][bj];
                    f32x4 v0 = acc[ai][bj][m][0], v1 = acc[ai][bj][m][1];
                    v0[0] += __uint_as_float(b4.x << 16); v0[1] += __uint_as_float(b4.x & 0xffff0000u); v0[2] += __uint_as_float(b4.y << 16); v0[3] += __uint_as_float(b4.y & 0xffff0000u);
                    v1[0] += __uint_as_float(b4.z << 16); v1[1] += __uint_as_float(b4.z & 0xffff0000u); v1[2] += __uint_as_float(b4.w << 16); v1[3] += __uint_as_float(b4.w & 0xffff0000u);
                    u32x4 w; w.x = pk2(v0[0], v0[1]); w.y = pk2(v0[2], v0[3]); w.z = pk2(v1[0], v1[1]); w.w = pk2(v1[2], v1[3]);
                    *(u32x4*)(hb + off + bj * HALF) = w;
                    sq += (v0[0] * v0[0] + v0[1] * v0[1]) + (v0[2] * v0[2] + v0[3] * v0[3]) + (v1[0] * v1[0] + v1[1] * v1[1]) + (v1[2] * v1[2] + v1[3] * v1[3]);
                }
                sq = quad_sum(sq);
                if (fq == 0) ssq[(size_t)row * 16 + u.pn * 4 + wc] = sq;
            }
    }
};
struct EpiRope {
    static constexpr bool PERM = false, AFTER_DRAIN = false;
    bf16_t* O; const float* ssq; const f32x2* tab;
    __device__ __forceinline__ void operator()(const f32x4 (&acc)[2][2][4][2], const Unit& u, int wr, int wc, int fr, int fq) const {
        const int row0 = u.pm * BM + wr * 64 + fr;
        const int hh = wc & 1;
        float rs[8];
        rstd8(ssq, row0, fq, rs);
#pragma unroll
        for (int ai = 0; ai < 2; ++ai) {
            f32x4 tb[4][2];
#pragma unroll
            for (int i = 0; i < 4; ++i) {
                const int pos = (row0 + ai * HALF + i * 16) & (SEQ - 1);
                const f32x4* t4 = (const f32x4*)(tab + (size_t)pos * 32 + 16 * hh + 4 * fq);
                tb[i][0] = t4[0]; tb[i][1] = t4[1];
            }
            __builtin_amdgcn_sched_barrier(0);
#pragma unroll
            for (int m = 0; m < 4; ++m) {
                const int row = row0 + ai * HALF + m * 16;
                const float r1 = rs[ai * 4 + m];
                const size_t hrow = (size_t)(row >> 11) * 36 * SEQ + (row & (SEQ - 1));
#pragma unroll
                for (int bj = 0; bj < 2; ++bj) {
                    const int gcol = u.pn * BM + bj * HALF + wc * 32;
                    const bool rope = (gcol < 1024) || (gcol >= 1536 && gcol < 2176);
                    f32x4 a = acc[ai][bj][m][0] * r1, b = acc[ai][bj][m][1] * r1;
                    int ca, cb;
                    if (rope) {
                        const f32x4 t0 = tb[m][0], t1 = tb[m][1];
                        f32x4 x1, x2;
                        x1[0] = a[0] * t0[0] - b[0] * t0[1]; x2[0] = b[0] * t0[0] + a[0] * t0[1];
                        x1[1] = a[1] * t0[2] - b[1] * t0[3]; x2[1] = b[1] * t0[2] + a[1] * t0[3];
                        x1[2] = a[2] * t1[0] - b[2] * t1[1]; x2[2] = b[2] * t1[0] + a[2] * t1[1];
                        x1[3] = a[3] * t1[2] - b[3] * t1[3]; x2[3] = b[3] * t1[2] + a[3] * t1[3];
                        a = x1; b = x2;
                        ca = (gcol & ~63) + 16 * hh + 4 * fq; cb = ca + 32;
                    } else { ca = gcol + 4 * fq; cb = ca + 16; }
                    u32x2 wa, wb; wa.x = pk2(a[0], a[1]); wa.y = pk2(a[2], a[3]); wb.x = pk2(b[0], b[1]); wb.y = pk2(b[2], b[3]);
                    bf16_t* hp = O + (hrow + (size_t)(ca >> 6) * SEQ) * 64;
                    *(u32x2*)(hp + (ca & 63)) = wa; *(u32x2*)(hp + (cb & 63)) = wb;
                }
            }
        }
    }
};

template <class Epi, class Sched, bool ALIGN_EPI = false, bool SP2 = false>
__device__ __forceinline__ void gemm_phase(PG8_LAS unsigned char* lds, const Gemm g, const Sched& S, const Epi& E) {
    int tid_l = threadIdx.x; asm volatile("" : "+v"(tid_l)); const int tid = tid_l, wid = __builtin_amdgcn_readfirstlane(tid >> 6), lane = tid & 63, wr = wid >> 2, wc = wid & 3, fr = lane & 15, fq = lane >> 4;
    const int K = g.K, nt = K / BK;
    unsigned voffA[2], voffB[2];
#pragma unroll
    for (int i = 0; i < 2; ++i) { int R, C; stage_rc(tid * 16 + i * 8192, R, C); const int Rb = Epi::PERM ? ((R & ~31) + perm32(R & 31)) : R;
        voffA[i] = (unsigned)(R * K + C) * 2u; voffB[i] = (unsigned)(Rb * K + C) * 2u; }
    const size_t kstep = (size_t)(BK * 2);
    const size_t hstep = (size_t)HALF * K * 2;
    const size_t tstep = 2 * hstep;
    const unsigned ldsw = (unsigned)wid * 1024u;
    const int aoff = lds_byte(wr * 64 + fr, fq * 8), boff = lds_byte(wc * 32 + fr, fq * 8);
#define PG8_SA(b, h) (((b) * 2 + (h)) * HTB)
#define PG8_SB(b, h) ((4 + (b) * 2 + (h)) * HTB)
#define PG8_STAGE(bufoff, gbase, voff) do { _Pragma("unroll") for (int _i = 0; _i < 2; ++_i) \
        __builtin_amdgcn_global_load_lds((const unsigned*)((const char*)(gbase) + (voff)[_i]), (PG8_LAS unsigned*)(lds + (bufoff) + ldsw + _i * 8192), 16, 0, 0); } while (0)
#define PG8_LDA(dst, b, h) do { _Pragma("unroll") for (int m = 0; m < 4; ++m) _Pragma("unroll") for (int k = 0; k < 2; ++k) dst[m][k] = *(const PG8_LAS bf16x8*)(lds + PG8_SA(b, h) + aoff + m * 2048 + k * 1024); } while (0)
#define PG8_LDB(dst, b, h) do { _Pragma("unroll") for (int n = 0; n < 2; ++n) _Pragma("unroll") for (int k = 0; k < 2; ++k) dst[n][k] = *(const PG8_LAS bf16x8*)(lds + PG8_SB(b, h) + boff + n * 2048 + k * 1024); } while (0)
#define PG8_MMA(ai, bj, At, Bt) do { __builtin_amdgcn_s_setprio(1); _Pragma("unroll") for (int m = 0; m < 4; ++m) _Pragma("unroll") for (int n = 0; n < 2; ++n) _Pragma("unroll") for (int k = 0; k < 2; ++k) \
        acc[ai][bj][m][n] = __builtin_amdgcn_mfma_f32_16x16x32_bf16(Bt[n][k], At[m][k], acc[ai][bj][m][n], 0, 0, 0); __builtin_amdgcn_s_setprio(0); } while (0)
#define PG8_WAIT_V(n) asm volatile("s_waitcnt vmcnt(" #n ")" ::: "memory")
#define PG8_WAIT_L(n) asm volatile("s_waitcnt lgkmcnt(" #n ")" ::: "memory")
#define PG8_BAR __builtin_amdgcn_s_barrier()
#define PG8_SCHED __builtin_amdgcn_sched_barrier(0)
    Unit cur, nxt; int ui = 0;
    if (!S.next(0, cur)) return;
    f32x4 acc[2][2][4][2];
#pragma unroll
    for (int a = 0; a < 2; ++a)
#pragma unroll
        for (int b = 0; b < 2; ++b)
#pragma unroll
            for (int m = 0; m < 4; ++m)
#pragma unroll
                for (int n = 0; n < 2; ++n) acc[a][b][m][n] = (f32x4){0.f, 0.f, 0.f, 0.f};
    bf16x8 At[4][2], B0[2][2], B1[2][2];
    const char* cA = (const char*)g.A + (size_t)cur.pm * tstep; const char* cB = (const char*)g.Bt + (size_t)cur.pn * tstep;
    S.a_ready(cur);
    if constexpr (SP2) {
        PG8_STAGE(PG8_SB(0, 0), cB, voffB); PG8_STAGE(PG8_SB(0, 1), cB + hstep, voffB); PG8_STAGE(PG8_SA(0, 0), cA, voffA); PG8_STAGE(PG8_SA(0, 1), cA + hstep, voffA);
        if (wr == 1) PG8_BAR;
        PG8_WAIT_V(2); PG8_BAR;
        PG8_STAGE(PG8_SB(1, 0), cB + kstep, voffB); PG8_STAGE(PG8_SA(1, 0), cA + kstep, voffA); PG8_STAGE(PG8_SB(1, 1), cB + hstep + kstep, voffB);
        PG8_WAIT_V(6); PG8_BAR;
    } else {
        PG8_STAGE(PG8_SB(0, 0), cB, voffB); PG8_STAGE(PG8_SA(0, 0), cA, voffA); PG8_STAGE(PG8_SB(0, 1), cB + hstep, voffB); PG8_STAGE(PG8_SA(0, 1), cA + hstep, voffA);
        if (wr == 1) PG8_BAR;
        PG8_WAIT_V(4); PG8_BAR;
        PG8_STAGE(PG8_SB(1, 0), cB + kstep, voffB); PG8_STAGE(PG8_SA(1, 0), cA + kstep, voffA); PG8_STAGE(PG8_SB(1, 1), cB + hstep + kstep, voffB);
        PG8_WAIT_V(6); PG8_BAR;
    }
    for (;;) {
        const bool has_next = S.next(ui + 1, nxt);
        const char* nA = has_next ? (const char*)g.A + (size_t)nxt.pm * tstep : cA; const char* nB = has_next ? (const char*)g.Bt + (size_t)nxt.pn * tstep : cB;
        for (int t = 0; t < nt; t += 2) {
            const bool last = (t == nt - 2);
            const char* a1 = cA + (size_t)(t + 1) * kstep;
            const char* a2 = last ? nA : cA + (size_t)(t + 2) * kstep; const char* b2 = last ? nB : cB + (size_t)(t + 2) * kstep;
            const char* a3 = a2 + kstep; const char* b3 = b2 + kstep;
            if (last && has_next) S.a_ready(nxt);
            if constexpr (SP2) {
            PG8_LDB(B0, 0, 0); PG8_LDB(B1, 0, 1); PG8_SCHED; PG8_LDA(At, 0, 0); PG8_STAGE(PG8_SA(1, 1), a1 + hstep, voffA);
            PG8_WAIT_V(8); PG8_WAIT_L(0); PG8_BAR; PG8_MMA(0, 0, At, B0); PG8_MMA(0, 1, At, B1); PG8_BAR; PG8_SCHED;
            PG8_LDA(At, 0, 1); PG8_STAGE(PG8_SB(0, 0), b2, voffB); PG8_STAGE(PG8_SB(0, 1), b2 + hstep, voffB); PG8_STAGE(PG8_SA(0, 0), a2, voffA);
            PG8_WAIT_V(8); PG8_WAIT_L(0); PG8_BAR; PG8_MMA(1, 0, At, B0); PG8_MMA(1, 1, At, B1); PG8_BAR; PG8_SCHED;
            PG8_LDB(B0, 1, 0); PG8_LDB(B1, 1, 1); PG8_SCHED; PG8_LDA(At, 1, 0); PG8_STAGE(PG8_SA(0, 1), a2 + hstep, voffA);
            PG8_WAIT_V(8); PG8_WAIT_L(0); PG8_BAR; PG8_MMA(0, 0, At, B0); PG8_MMA(0, 1, At, B1); PG8_BAR; PG8_SCHED;
            PG8_LDA(At, 1, 1); PG8_STAGE(PG8_SB(1, 0), b3, voffB); PG8_STAGE(PG8_SB(1, 1), b3 + hstep, voffB); PG8_STAGE(PG8_SA(1, 0), a3, voffA);
            PG8_WAIT_V(8); PG8_WAIT_L(0); PG8_BAR; PG8_MMA(1, 0, At, B0); PG8_MMA(1, 1, At, B1); PG8_BAR; PG8_SCHED;
            } else {
            PG8_LDB(B0, 0, 0); PG8_SCHED; PG8_LDA(At, 0, 0); PG8_STAGE(PG8_SA(1, 1), a1 + hstep, voffA);
            PG8_WAIT_L(8); PG8_BAR; PG8_WAIT_L(0); PG8_MMA(0, 0, At, B0); PG8_BAR; PG8_SCHED;
            PG8_LDB(B1, 0, 1); PG8_STAGE(PG8_SB(0, 0), b2, voffB);
            PG8_BAR; PG8_WAIT_L(0); PG8_MMA(0, 1, At, B1); PG8_BAR;
            PG8_LDA(At, 0, 1); PG8_STAGE(PG8_SA(0, 0), a2, voffA);
            PG8_BAR; PG8_WAIT_L(0); PG8_MMA(1, 0, At, B0); PG8_BAR; PG8_SCHED;
            PG8_STAGE(PG8_SB(0, 1), b2 + hstep, voffB);
            PG8_WAIT_V(6); PG8_BAR; PG8_MMA(1, 1, At, B1); PG8_BAR;
            PG8_LDB(B0, 1, 0); PG8_SCHED; PG8_LDA(At, 1, 0); PG8_STAGE(PG8_SA(0, 1), a2 + hstep, voffA);
            PG8_WAIT_L(8); PG8_BAR; PG8_WAIT_L(0); PG8_MMA(0, 0, At, B0); PG8_BAR; PG8_SCHED;
            PG8_LDB(B1, 1, 1); PG8_STAGE(PG8_SB(1, 0), b3, voffB);
            PG8_BAR; PG8_WAIT_L(0); PG8_MMA(0, 1, At, B1); PG8_BAR;
            PG8_LDA(At, 1, 1); PG8_STAGE(PG8_SA(1, 0), a3, voffA);
            PG8_BAR; PG8_WAIT_L(0); PG8_MMA(1, 0, At, B0); PG8_BAR; PG8_SCHED;
            PG8_STAGE(PG8_SB(1, 1), b3 + hstep, voffB);
            PG8_WAIT_V(6); PG8_BAR; PG8_MMA(1, 1, At, B1); PG8_BAR;
            }
        }
        if constexpr (ALIGN_EPI) { if (wr == 0) PG8_BAR; }
        if constexpr (!Epi::AFTER_DRAIN) { E(acc, cur, wr, wc, fr, fq); S.done(cur); }
        if (!has_next) break;
#pragma unroll
        for (int a = 0; a < 2; ++a)
#pragma unroll
            for (int b = 0; b < 2; ++b)
#pragma unroll
                for (int m = 0; m < 4; ++m)
#pragma unroll
                    for (int n = 0; n < 2; ++n) acc[a][b][m][n] = (f32x4){0.f, 0.f, 0.f, 0.f};
        cur = nxt; cA = nA; cB = nB; ++ui;
        if constexpr (ALIGN_EPI) { if (wr == 1) PG8_BAR; }
    }
    PG8_WAIT_V(0);
    if constexpr (!ALIGN_EPI) { if (wr == 0) PG8_BAR; }
    PG8_BAR;
    if constexpr (Epi::AFTER_DRAIN) { E.fused(acc, cur, wr, wc, fr, fq, lds, wid, lane); S.done(cur); }
#undef PG8_SA
#undef PG8_SB
#undef PG8_STAGE
#undef PG8_LDA
#undef PG8_LDB
#undef PG8_MMA
#undef PG8_WAIT_V
#undef PG8_WAIT_L
#undef PG8_BAR
#undef PG8_SCHED
}
}

constexpr size_t MiB = 1024 * 1024;
constexpr size_t WS_WIN0 = 0;
constexpr size_t WS_WOUT0 = WS_WIN0 + (size_t)ABN * DM * 2;
constexpr size_t WS_WIN1 = WS_WOUT0 + 2 * MiB;
constexpr size_t WS_WOUT1 = WS_WIN1 + (size_t)CDN * DM * 2;
constexpr size_t WS_WQ = WS_WOUT1 + 2 * MiB;
constexpr size_t WS_WKV = WS_WQ + 4 * MiB;
constexpr size_t WS_WO = WS_WKV + 8 * MiB;
constexpr size_t WS_WUP = WS_WO + 4 * MiB;
constexpr size_t WS_WDN = WS_WUP + 16 * MiB;
constexpr size_t WS_HB = WS_WDN + 16 * MiB;
constexpr size_t WS_SSQ = WS_HB + 128 * MiB;
constexpr size_t WS_R1 = WS_SSQ + 4 * MiB;
constexpr size_t WS_Y = WS_R1 + 512 * MiB;
constexpr size_t WS_KV = WS_Y + 128 * MiB;
constexpr size_t WS_MEMN = WS_KV + 64 * MiB;
constexpr size_t WS_CS = WS_MEMN + 32 * MiB;
constexpr size_t WS_FL = WS_CS + 2 * MiB;
constexpr size_t WS_ROPE = WS_FL + 2 * MiB;
constexpr size_t WS_BAR = WS_ROPE + MiB / 2;
constexpr size_t WS_BAR_BYTES = 32768;
constexpr size_t WS_END = WS_BAR + WS_BAR_BYTES;
static_assert(WS_END <= 1024 * MiB, "workspace");
static_assert(WS_WOUT1 % 256 == 0 && WS_HB % 256 == 0, "align");

constexpr int LDS_BYTES = 155648;

struct Params { const float* in[26]; float* out; unsigned char* ws; };
__device__ __forceinline__ unsigned hw_xcc_id() { return (unsigned)__builtin_amdgcn_s_getreg((3 << 11) | 20) & 0xFu; }

__device__ __forceinline__ int colmap1(int n) {
    const bool rope = (n < 1024) || (n >= 1536 && n < 2176);
    if (!rope) return n;
    const int p = n & 63, hh = p >> 5, pp = p & 31;
    const int orig = (pp < 16) ? (16 * hh + pp) : (32 + 16 * hh + pp - 16);
    return (n & ~63) + orig;
}
__device__ __forceinline__ void conv_weight(LAS float* tile, const float* __restrict__ src, bf16_t* __restrict__ dst, const float* __restrict__ gain, int K, int N, int ldsrc, int mode,
                                            float qs, int qlo, int qhi, int q2lo, int q2hi, int& base) {
    const int G = gridDim.x, tid = threadIdx.x;
    const int nkt = K >> 6, ntiles = nkt * (N >> 6);
    int start = ((int)blockIdx.x - base) % G; if (start < 0) start += G;
    for (int t = start; t < ntiles; t += G) {
        const int k0 = (t % nkt) << 6, n0 = (t / nkt) << 6;
        {
            const int c = tid & 63, r0 = tid >> 6, n = n0 + c;
            const int sc = mode ? colmap1(n) : n;
            const float cs = ((n >= qlo && n < qhi) || (n >= q2lo && n < q2hi)) ? qs : 1.0f;
#pragma unroll
            for (int i = 0; i < 8; ++i) {
                const int r = r0 + 8 * i, k = k0 + r;
                float v = src[(size_t)k * ldsrc + sc] * cs;
                if (gain) v *= gain[k];
                tile[r * 65 + c] = v;
            }
        }
        __syncthreads();
        {
            const int rr = tid >> 3, ch = tid & 7;
            float v[8];
#pragma unroll
            for (int j = 0; j < 8; ++j) v[j] = tile[(ch * 8 + j) * 65 + rr];
            u32x4 w; w.x = pk2(v[0], v[1]); w.y = pk2(v[2], v[3]); w.z = pk2(v[4], v[5]); w.w = pk2(v[6], v[7]);
            *(u32x4*)(dst + (size_t)(n0 + rr) * K + k0 + ch * 8) = w;
        }
        __syncthreads();
    }
    base = (base + ntiles) % G;
}

__device__ __forceinline__ void p0_prologue(const Params& p, LAS unsigned char* lds) {
    unsigned char* ws = p.ws;
    int tid_l = threadIdx.x; asm volatile("" : "+v"(tid_l)); const int tid = tid_l, lane = tid & 63, wid = tid >> 6, G = gridDim.x;
    LAS float* tile = (LAS float*)lds;
    int base = 0;
    const float QS64 = 0.125f * LOG2E, QS256 = 0.0625f * LOG2E;
    conv_weight(tile, p.in[3], (bf16_t*)(ws + WS_WIN0), p.in[2], DM, ABN, AB_IN, 0, QS64, 1024, 1536, 0, 0, base);
    conv_weight(tile, p.in[12], (bf16_t*)(ws + WS_WOUT0), nullptr, DM, DM, DM, 0, 1.f, 0, 0, 0, 0, base);
    conv_weight(tile, p.in[14], (bf16_t*)(ws + WS_WIN1), p.in[13], DM, CDN, CDN, 1, QS64, 0, 512, 1536, 2048, base);
    conv_weight(tile, p.in[16], (bf16_t*)(ws + WS_WOUT1), nullptr, DM, DM, DM, 0, 1.f, 0, 0, 0, 0, base);
    for (int l = 0; l < 2; ++l) {
        conv_weight(tile, p.in[19] + (size_t)l * DM * DM, (bf16_t*)(ws + WS_WQ + l * 2 * MiB), p.in[17] + l * DM, DM, DM, DM, 0, QS256, 0, DM, 0, 0, base);
        conv_weight(tile, p.in[20] + (size_t)l * DM * 2 * DM, (bf16_t*)(ws + WS_WKV + l * 4 * MiB), nullptr, DM, 2 * DM, 2 * DM, 0, 1.f, 0, 0, 0, 0, base);
        conv_weight(tile, p.in[21] + (size_t)l * DM * DM, (bf16_t*)(ws + WS_WO + l * 2 * MiB), nullptr, DM, DM, DM, 0, 1.f, 0, 0, 0, 0, base);
        conv_weight(tile, p.in[23] + (size_t)l * DM * DFF, (bf16_t*)(ws + WS_WUP + l * 8 * MiB), p.in[22] + l * DM, DM, DFF, DFF, 0, 1.f, 0, 0, 0, 0, base);
        conv_weight(tile, p.in[24] + (size_t)l * DFF * DM, (bf16_t*)(ws + WS_WDN + l * 8 * MiB), nullptr, DFF, DM, DM, 0, 1.f, 0, 0, 0, 0, base);
    }
    __syncthreads();
    LAS float* wf = (LAS float*)lds;
    for (int i = tid; i < 8 * DM; i += 512) { const int j = i >> 10, k = i & 1023; wf[i] = p.in[3][(size_t)k * AB_IN + ABN + j] * p.in[2][k]; }
    __syncthreads();
    const int gw = blockIdx.x * 8 + wid, NGW = G * 8;
    bf16_t* hb = (bf16_t*)(ws + WS_HB);
    float* ssq = (float*)(ws + WS_SSQ);
    float* fl = (float*)(ws + WS_FL);
    f32x4 vn[4];
    if (gw < MTOK) {
        const f32x4* xr0 = (const f32x4*)(p.in[0] + (size_t)gw * DM);
#pragma unroll
        for (int i = 0; i < 4; ++i) vn[i] = __builtin_nontemporal_load(xr0 + lane + 64 * i);
    }
    for (int row = gw; row < MTOK; row += NGW) {
        f32x4 v[4];
#pragma unroll
        for (int i = 0; i < 4; ++i) v[i] = vn[i];
        if (row + NGW < MTOK) {
            const f32x4* xr = (const f32x4*)(p.in[0] + (size_t)(row + NGW) * DM);
#pragma unroll
            for (int i = 0; i < 4; ++i) vn[i] = __builtin_nontemporal_load(xr + lane + 64 * i);
        }
        float s = 0.f, a[8];
#pragma unroll
        for (int j = 0; j < 8; ++j) a[j] = 0.f;
#pragma unroll
        for (int i = 0; i < 4; ++i) {
            s += (v[i][0] * v[i][0] + v[i][1] * v[i][1]) + (v[i][2] * v[i][2] + v[i][3] * v[i][3]);
#pragma unroll
            for (int j = 0; j < 8; ++j) { const f32x4 w = *(const LAS f32x4*)(wf + j * DM + 4 * (lane + 64 * i)); a[j] += (v[i][0] * w[0] + v[i][1] * w[1]) + (v[i][2] * w[2] + v[i][3] * w[3]); }
            u32x2 w2; w2.x = pk2(v[i][0], v[i][1]); w2.y = pk2(v[i][2], v[i][3]);
            *(u32x2*)(hb + (size_t)row * DM + 4 * (lane + 64 * i)) = w2;
        }
        s = wave_sum(s);
        const float rs = 1.0f / sqrtf(s * (1.0f / 1024.0f) + EPS);
        float mine = 0.f;
#pragma unroll
        for (int j = 0; j < 8; ++j) { const float t = wave_sum(a[j]) * rs; if (lane == j) mine = t; }
        if (lane < 8) fl[(size_t)row * 8 + lane] = mine;
        if (lane < 16) ssq[(size_t)row * 16 + lane] = (lane == 0) ? s : 0.f;
    }
    for (int row = gw; row < MMEM; row += NGW) {
        const f32x4* xr = (const f32x4*)(p.in[1] + (size_t)row * DM);
        f32x4 v[4];
        float s = 0.f;
#pragma unroll
        for (int i = 0; i < 4; ++i) { v[i] = xr[lane + 64 * i]; s += (v[i][0] * v[i][0] + v[i][1] * v[i][1]) + (v[i][2] * v[i][2] + v[i][3] * v[i][3]); }
        s = wave_sum(s);
        const float rs = 1.0f / sqrtf(s * (1.0f / 1024.0f) + EPS);
#pragma unroll
        for (int l = 0; l < 2; ++l) {
            bf16_t* dst = (bf16_t*)(ws + WS_MEMN + l * 16 * MiB) + (size_t)row * DM;
#pragma unroll
            for (int i = 0; i < 4; ++i) {
                const f32x4 g = *(const f32x4*)(p.in[18] + l * DM + 4 * (lane + 64 * i));
                u32x2 w2; w2.x = pk2(v[i][0] * rs * g[0], v[i][1] * rs * g[1]); w2.y = pk2(v[i][2] * rs * g[2], v[i][3] * rs * g[3]);
                *(u32x2*)(dst + 4 * (lane + 64 * i)) = w2;
            }
        }
    }
    f32x2* tab = (f32x2*)(ws + WS_ROPE);
    for (int idx = blockIdx.x * 512 + tid; idx < SEQ * 32; idx += G * 512) {
        const int pos = idx >> 5, i = idx & 31;
        const float inv = exp2f(-(float)i * (13.287712379549449f / 32.0f));
        const float ang = (float)pos * inv;
        f32x2 cs; cs[0] = cosf(ang); cs[1] = sinf(ang);
        tab[idx] = cs;
    }
    __syncthreads();
}

__device__ __forceinline__ void fox_cumsum(const Params& p) {
    int tid_l = threadIdx.x; asm volatile("" : "+v"(tid_l)); const int tid = tid_l, lane = tid & 63, wid = tid >> 6;
    if (wid != 0) return;
    const float* fl = (const float*)(p.ws + WS_FL);
    float* cs2 = (float*)(p.ws + WS_CS);
    for (int seq = blockIdx.x; seq < NB * 8; seq += gridDim.x) {
        const int b = seq >> 3, h = seq & 7;
        const float bf = p.in[11][h];
        const float* src = fl + ((size_t)b * SEQ + lane * 32) * 8 + h;
        float tot = 0.f;
        for (int i = 0; i < 32; ++i) { const float y = src[i * 8] + bf; tot += fminf(y, 0.f) - log1pf(expf(-fabsf(y))); }
        float incl = tot;
#pragma unroll
        for (int o = 1; o < 64; o <<= 1) { const float t = __shfl_up(incl, o); if (lane >= o) incl += t; }
        float run = incl - tot;
        float* dst = cs2 + (size_t)seq * SEQ + lane * 32;
        for (int i = 0; i < 32; ++i) { const float y = src[i * 8] + bf; run += fminf(y, 0.f) - log1pf(expf(-fabsf(y))); dst[i] = run * LOG2E; }
    }
}

__device__ __forceinline__ s16x4 vtr(LAS const unsigned char* p) { return __builtin_bit_cast(s16x4, __builtin_amdgcn_ds_read_tr16_b64_v4i16((LAS s16x4*)p)); }

template <int NKT, int QT, int DT, int KSTR, int VSTR, class F>
__device__ __forceinline__ void attn_stage(f32x4 (&O)[QT][DT], float (&mrow)[QT], float (&lsum)[QT], const bf16x8 (&Qf)[QT][DT / 2],
                                           LAS const unsigned char* Ks, LAS const unsigned char* Vs, const F& fn, int lane) {
    const int li = lane & 15, g = lane >> 4;
    constexpr int KS = DT / 2;
    constexpr int KTB = (KS >= 8) ? 1 : 2;
    constexpr int NKB = NKT / KTB;
    static_assert(NKT % KTB == 0 && NKT % 2 == 0, "attn_stage shape");
    f32x4 S[QT][NKT];
    if constexpr (KS >= 8) {
        constexpr int HB = KS / 4, NB = NKT * HB;
        bf16x8 kf[2][4];
        LAS const unsigned char* kbase = Ks + li * KSTR + 16 * g;
#pragma unroll
        for (int j = 0; j < 4; ++j) kf[0][j] = *(LAS const bf16x8*)(kbase + 64 * j);
#pragma unroll
        for (int bi = 0; bi < NB; ++bi) {
            if (bi + 1 < NB) {
                const int kt1 = (bi + 1) / HB, k1 = ((bi + 1) % HB) * 4;
#pragma unroll
                for (int j = 0; j < 4; ++j) kf[(bi + 1) & 1][j] = *(LAS const bf16x8*)(kbase + (16 * kt1) * KSTR + 64 * (k1 + j));
            }
            __builtin_amdgcn_sched_barrier(0); __builtin_amdgcn_s_setprio(1);
            const int kt = bi / HB, k0 = (bi % HB) * 4;
            if (k0 == 0) {
                const f32x4 s0 = fn.init(kt);
#pragma unroll
                for (int qt = 0; qt < QT; ++qt) S[qt][kt] = s0;
            }
#pragma unroll
            for (int j = 0; j < 4; ++j)
#pragma unroll
                for (int qt = 0; qt < QT; ++qt) S[qt][kt] = __builtin_amdgcn_mfma_f32_16x16x32_bf16(kf[bi & 1][j], Qf[qt][k0 + j], S[qt][kt], 0, 0, 0);
__builtin_amdgcn_s_setprio(0); __builtin_amdgcn_sched_barrier(0);
        }
    } else {
        bf16x8 kf[2][KTB][KS];
        LAS const unsigned char* kbase = Ks + li * KSTR + 16 * g;
#pragma unroll
        for (int t = 0; t < KTB; ++t)
#pragma unroll
            for (int ks = 0; ks < KS; ++ks) kf[0][t][ks] = *(LAS const bf16x8*)(kbase + (16 * t) * KSTR + 64 * ks);
#pragma unroll
        for (int kb = 0; kb < NKB; ++kb) {
            if (kb + 1 < NKB) {
#pragma unroll
                for (int t = 0; t < KTB; ++t)
#pragma unroll
                    for (int ks = 0; ks < KS; ++ks) kf[(kb + 1) & 1][t][ks] = *(LAS const bf16x8*)(kbase + (16 * ((kb + 1) * KTB + t)) * KSTR + 64 * ks);
            }
            __builtin_amdgcn_sched_barrier(0); __builtin_amdgcn_s_setprio(1);
#pragma unroll
            for (int t = 0; t < KTB; ++t) {
                const int kt = kb * KTB + t;
                const f32x4 s0 = fn.init(kt);
#pragma unroll
                for (int qt = 0; qt < QT; ++qt) S[qt][kt] = s0;
#pragma unroll
                for (int ks = 0; ks < KS; ++ks)
#pragma unroll
                    for (int qt = 0; qt < QT; ++qt) S[qt][kt] = __builtin_amdgcn_mfma_f32_16x16x32_bf16(kf[kb & 1][t][ks], Qf[qt][ks], S[qt][kt], 0, 0, 0);
            }
__builtin_amdgcn_s_setprio(0); __builtin_amdgcn_sched_barrier(0);
        }
    }
#pragma unroll
    for (int qt = 0; qt < QT; ++qt) {
        float mx = -INFINITY;
#pragma unroll
        for (int kt = 0; kt < NKT; ++kt) { S[qt][kt] = fn.apply(S[qt][kt], qt, kt); mx = max3f(mx, S[qt][kt][0], S[qt][kt][1]); mx = max3f(mx, S[qt][kt][2], S[qt][kt][3]); }
        mx = quad_max(mx);
        const float mnew = max2f(mrow[qt], mx);
        const float msub = (mnew == -INFINITY) ? 0.f : mnew;
        const float alpha = ex2(mrow[qt] - msub);
        mrow[qt] = mnew;
        float ps = 0.f;
#pragma unroll
        for (int kt = 0; kt < NKT; ++kt)
#pragma unroll
            for (int e = 0; e < 4; ++e) { const float pv = ex2(S[qt][kt][e] - msub); S[qt][kt][e] = pv; ps += pv; }
        lsum[qt] = lsum[qt] * alpha + ps;
#pragma unroll
        for (int dt = 0; dt < DT; ++dt) O[qt][dt] = O[qt][dt] * alpha;
    }
    {
        constexpr int NS = NKT / 2;
        constexpr int DTB = (DT > 4) ? 4 : DT;
        constexpr int NDB = DT / DTB, NVB = NS * NDB;
        bf16x8 Pf[QT][NS];
#pragma unroll
        for (int s = 0; s < NS; ++s)
#pragma unroll
            for (int qt = 0; qt < QT; ++qt) {
                u32x4 w; w.x = pk2(S[qt][2 * s][0], S[qt][2 * s][1]); w.y = pk2(S[qt][2 * s][2], S[qt][2 * s][3]);
                w.z = pk2(S[qt][2 * s + 1][0], S[qt][2 * s + 1][1]); w.w = pk2(S[qt][2 * s + 1][2], S[qt][2 * s + 1][3]);
                Pf[qt][s] = __builtin_bit_cast(bf16x8, w);
            }
        const int q = li >> 2, pp = li & 3;
        LAS const unsigned char* vbase = Vs + (4 * g + q) * VSTR + 8 * pp;
        s16x4 va[2][DTB][2];
#pragma unroll
        for (int j = 0; j < DTB; ++j) { va[0][j][0] = vtr(vbase + 32 * j); va[0][j][1] = vtr(vbase + 16 * VSTR + 32 * j); }
#pragma unroll
        for (int bi = 0; bi < NVB; ++bi) {
            if (bi + 1 < NVB) {
                const int s1 = (bi + 1) / NDB, d1 = ((bi + 1) % NDB) * DTB;
#pragma unroll
                for (int j = 0; j < DTB; ++j) { va[(bi + 1) & 1][j][0] = vtr(vbase + (32 * s1) * VSTR + 32 * (d1 + j)); va[(bi + 1) & 1][j][1] = vtr(vbase + (32 * s1 + 16) * VSTR + 32 * (d1 + j)); }
            }
            __builtin_amdgcn_sched_barrier(0); __builtin_amdgcn_s_setprio(1);
            const int s = bi / NDB, d0 = (bi % NDB) * DTB;
#pragma unroll
            for (int j = 0; j < DTB; ++j) {
                const s16x4 a1 = va[bi & 1][j][0], a2 = va[bi & 1][j][1];
                const bf16x8 vf = (bf16x8){a1[0], a1[1], a1[2], a1[3], a2[0], a2[1], a2[2], a2[3]};
#pragma unroll
                for (int qt = 0; qt < QT; ++qt) O[qt][d0 + j] = __builtin_amdgcn_mfma_f32_16x16x32_bf16(vf, Pf[qt][s], O[qt][d0 + j], 0, 0, 0);
            }
__builtin_amdgcn_s_setprio(0); __builtin_amdgcn_sched_barrier(0);
        }
    }
}

__device__ __forceinline__ float rcp_(float x) { return __builtin_amdgcn_rcpf(x); }
__device__ __forceinline__ float sigmoidf_(float x) { return rcp_(1.0f + ex2(-LOG2E * x)); }
__device__ __forceinline__ float gelu_tanh(float x) { const float y = 0.7978845608028654f * (x + 0.044715f * x * x * x); const float t = 1.0f - 2.0f * rcp_(1.0f + ex2((2.0f * LOG2E) * y)); return 0.5f * x * (1.0f + t); }
__device__ __forceinline__ float one_minus_exp(float x) {
    const float p = -x * (1.0f + x * (0.5f + x * ((1.0f / 6.0f) + x * ((1.0f / 24.0f) + x * ((1.0f / 120.0f) + x * (1.0f / 720.0f))))));
    const float d = 1.0f - ex2(LOG2E * x);
    return (x < -0.3f) ? d : p;
}

__device__ __forceinline__ void lru_phase(const Params& p, LAS unsigned char* lds) {
    int tid_l = threadIdx.x; asm volatile("" : "+v"(tid_l)); const int tid = tid_l, lane = tid & 63, wid = tid >> 6, li = lane & 15, g4 = lane >> 4;
    const bf16_t* Z = (const bf16_t*)(p.ws + WS_R1);
    bf16_t* Y = (bf16_t*)(p.ws + WS_Y);
    LAS float* ucf = (LAS float*)lds;
    LAS bf16_t* ucb = (LAS bf16_t*)(lds + 32768);
    LAS bf16_t* wcat = (LAS bf16_t*)(lds + 32768 + 18432);
    LAS float* af = (LAS float*)(lds + 32768 + 2 * 18432);
    LAS float* wst = (LAS float*)(lds + 32768 + 2 * 18432 + 32768);
    LAS float* carry = wst + 1024;
    for (int unit = blockIdx.x; unit < NB * 8; unit += gridDim.x) {
        const int b = unit >> 3, gb = unit & 7;
        __syncthreads();
        for (int idx = tid; idx < 64 * 128; idx += 512) {
            const int n = idx & 127, c = idx >> 7;
            const float w = (n < 64) ? p.in[6][((size_t)gb * 64 + c) * 64 + n] : p.in[8][((size_t)gb * 64 + c) * 64 + (n - 64)];
            wcat[n * 72 + c] = (bf16_t)f2bf(w);
        }
        if (tid < 128) carry[tid] = 0.f;
        const int ch = gb * 64 + lane;
        const float cw0 = p.in[4][0 * 512 + ch], cw1 = p.in[4][1 * 512 + ch], cw2 = p.in[4][2 * 512 + ch], cw3 = p.in[4][3 * 512 + ch], cb = p.in[5][ch];
        float ba[4], bi[4], sp8[4];
#pragma unroll
        for (int nt = 0; nt < 4; ++nt) {
            const int d = gb * 64 + 16 * nt + li;
            ba[nt] = p.in[7][d]; bi[nt] = p.in[9][d];
            const float lam = p.in[10][d];
            sp8[nt] = 8.0f * (fmaxf(-lam, 0.f) + log1pf(expf(-fabsf(lam))));
        }
        __syncthreads();
        const bf16_t* zb = Z + (size_t)b * SEQ * ABN;
        unsigned un[10];
        {
            const int tw = 16 * wid;
#pragma unroll
            for (int j = 0; j < 10; ++j) {
                const int r0 = tw - 3 + 2 * j, r1 = r0 + 1;
                const unsigned a = (r0 >= 0) ? zb[(size_t)r0 * ABN + ch] : 0u;
                const unsigned bb = (j < 9 && r1 >= 0) ? zb[(size_t)r1 * ABN + ch] : 0u;
                un[j] = a | (bb << 16);
            }
        }
        for (int tc = 0; tc < SEQ / 128; ++tc) {
            const int t0 = tc * 128, tw = t0 + 16 * wid;
            unsigned uq[10], gq[8];
#pragma unroll
            for (int j = 0; j < 10; ++j) uq[j] = un[j];
#pragma unroll
            for (int j = 0; j < 8; ++j) { const unsigned a = zb[(size_t)(tw + 2 * j) * ABN + 512 + ch], bb = zb[(size_t)(tw + 2 * j + 1) * ABN + 512 + ch]; gq[j] = a | (bb << 16); }
            if (tc + 1 < SEQ / 128) {
#pragma unroll
                for (int j = 0; j < 10; ++j) {
                    const unsigned a = zb[(size_t)(tw + 128 - 3 + 2 * j) * ABN + ch];
                    const unsigned bb = (j < 9) ? zb[(size_t)(tw + 128 - 3 + 2 * j + 1) * ABN + ch] : 0u;
                    un[j] = a | (bb << 16);
                }
            }
#define UQ(k) (((k) & 1) ? __uint_as_float(uq[(k) >> 1] & 0xffff0000u) : __uint_as_float(uq[(k) >> 1] << 16))
#define GQ(k) (((k) & 1) ? __uint_as_float(gq[(k) >> 1] & 0xffff0000u) : __uint_as_float(gq[(k) >> 1] << 16))
            {
#pragma unroll
                for (int i = 0; i < 16; ++i) {
                    const float uc = cb + cw0 * UQ(i) + cw1 * UQ(i + 1) + cw2 * UQ(i + 2) + cw3 * UQ(i + 3);
                    const int r = 16 * wid + i;
                    ucf[r * 64 + lane] = uc; ucb[r * 72 + lane] = (bf16_t)f2bf(uc);
                }
            }
            __syncthreads();
            {
                f32x4 acc[8];
                bf16x8 af_[2];
#pragma unroll
                for (int ks = 0; ks < 2; ++ks) af_[ks] = *(LAS const bf16x8*)((LAS const unsigned char*)ucb + ((16 * wid + li) * 72 + 32 * ks + 8 * g4) * 2);
#pragma unroll
                for (int nt = 0; nt < 8; ++nt) {
                    acc[nt] = (f32x4){0.f, 0.f, 0.f, 0.f};
#pragma unroll
                    for (int ks = 0; ks < 2; ++ks) {
                        const bf16x8 bfr = *(LAS const bf16x8*)((LAS const unsigned char*)wcat + ((16 * nt + li) * 72 + 32 * ks + 8 * g4) * 2);
                        acc[nt] = __builtin_amdgcn_mfma_f32_16x16x32_bf16(af_[ks], bfr, acc[nt], 0, 0, 0);
                    }
                }
#pragma unroll
                for (int nt = 0; nt < 4; ++nt)
#pragma unroll
                    for (int e = 0; e < 4; ++e) {
                        const int r = 16 * wid + 4 * g4 + e, d = 16 * nt + li;
                        const float rg = sigmoidf_(acc[nt][e] + ba[nt]), ig = sigmoidf_(acc[nt + 4][e] + bi[nt]);
                        const float la = -sp8[nt] * rg;
                        const float a = ex2(LOG2E * la);
                        const float mult = __builtin_amdgcn_sqrtf(fmaxf(one_minus_exp(2.0f * la), 0.f));
                        const float uc = ucf[r * 64 + d];
                        ucf[r * 64 + d] = mult * ig * uc;
                        af[r * 64 + d] = a;
                    }
            }
            __syncthreads();
            {
                float A = 1.f, H = 0.f;
#pragma unroll 4
                for (int i = 0; i < 16; ++i) { const int r = 16 * wid + i; const float a = af[r * 64 + lane], x = ucf[r * 64 + lane]; H = a * H + x; A *= a; }
                wst[(wid * 2 + 0) * 64 + lane] = A; wst[(wid * 2 + 1) * 64 + lane] = H;
            }
            __syncthreads();
            {
                float h = carry[(tc & 1) * 64 + lane];
                for (int w = 0; w < wid; ++w) h = wst[(w * 2 + 0) * 64 + lane] * h + wst[(w * 2 + 1) * 64 + lane];
#pragma unroll
                for (int i = 0; i < 16; ++i) {
                    const int r = 16 * wid + i;
                    const float a = af[r * 64 + lane], x = ucf[r * 64 + lane];
                    h = a * h + x;
                    Y[((size_t)b * SEQ + tw + i) * DM + ch] = (bf16_t)f2bf(h * gelu_tanh(GQ(i)));
                }
                if (wid == 7) carry[((tc + 1) & 1) * 64 + lane] = h;
            }
            __syncthreads();
        }
    }
}

struct FoxFn {
    LAS const float* cs; int key0, row0; bool domask;
    __device__ __forceinline__ f32x4 init(int kt) const { return *(LAS const f32x4*)(cs + 16 * kt + (key0 & 12)); }
    __device__ __forceinline__ f32x4 apply(f32x4 s, int qt, int kt) const {
        f32x4 t = s;
        if (domask) {
            const int row = row0 + 16 * qt, kb = key0 + 16 * kt;
#pragma unroll
            for (int e = 0; e < 4; ++e) if (kb + e > row) t[e] = -INFINITY;
        }
        return t;
    }
};

__device__ __forceinline__ void fox_phase(const Params& p, LAS unsigned char* lds) {
    int tid_l = threadIdx.x; asm volatile("" : "+v"(tid_l)); const int tid = tid_l, lane = tid & 63, wid = __builtin_amdgcn_readfirstlane(tid >> 6), li = lane & 15, g = lane >> 4;
    const bf16_t* Z = (const bf16_t*)(p.ws + WS_R1);
    bf16_t* Y = (bf16_t*)(p.ws + WS_Y);
    const float* cs2 = (const float*)(p.ws + WS_CS);
    LAS unsigned char* Ks = lds;
    LAS unsigned char* Vs = lds + 20480;
    LAS float* csl = (LAS float*)(lds + 40960);
    const int nunits = NB * 8 * 4;
    const bool xmap = (gridDim.x == 256);
    const int vcu = __builtin_amdgcn_readfirstlane(*(volatile LAS int*)(lds + LDS_BYTES - 48));
    for (int unit = blockIdx.x; unit < nunits; unit += gridDim.x) {
        int bh = unit >> 2, pair = unit & 3;
        if (xmap) { bh = (vcu & 7) * 32 + (vcu >> 3); pair = unit >> 8; }
        const int b = bh >> 3, h = bh & 7;
        const bf16_t* zb = Z + (size_t)b * SEQ * ABN;
        for (int half = 0; half < 2; ++half) {
            const int qblk = half ? (7 - pair) : pair;
            const int q0 = qblk * 256, rw0 = q0 + 32 * wid;
            bf16x8 Qf[2][2];
#pragma unroll
            for (int qt = 0; qt < 2; ++qt)
#pragma unroll
                for (int ks = 0; ks < 2; ++ks) Qf[qt][ks] = *(const bf16x8*)(zb + (size_t)(rw0 + 16 * qt + li) * ABN + 1024 + 64 * h + 32 * ks + 8 * g);
            f32x4 O[2][4]; float mrow[2], lsum[2];
#pragma unroll
            for (int qt = 0; qt < 2; ++qt) { mrow[qt] = -INFINITY; lsum[qt] = 0.f;
#pragma unroll
                for (int dt = 0; dt < 4; ++dt) O[qt][dt] = (f32x4){0.f, 0.f, 0.f, 0.f}; }
            const int nst = 2 * (qblk + 1);
            u32x4 rk[2], rv[2]; float rc = 0.f;
#pragma unroll
            for (int i = 0; i < 2; ++i) { const int c = tid + 512 * i, row = c >> 3, ch = c & 7; const bf16_t* src = zb + (size_t)row * ABN + 1536 + 64 * h + 8 * ch; rk[i] = *(const u32x4*)src; rv[i] = *(const u32x4*)(src + 512); }
            if (tid < 128) rc = cs2[(size_t)bh * SEQ + tid];
            for (int st = 0; st < nst; ++st) {
                const int k0 = st * 128;
                __syncthreads();
#pragma unroll
                for (int i = 0; i < 2; ++i) { const int c = tid + 512 * i, row = c >> 3, ch = c & 7; *(LAS u32x4*)(Ks + row * 160 + ch * 16) = rk[i]; *(LAS u32x4*)(Vs + row * 160 + ch * 16) = rv[i]; }
                if (tid < 128) csl[tid] = -rc;
                __syncthreads();
                if (st + 1 < nst) {
#pragma unroll
                    for (int i = 0; i < 2; ++i) { const int c = tid + 512 * i, row = c >> 3, ch = c & 7; const bf16_t* src = zb + (size_t)(k0 + 128 + row) * ABN + 1536 + 64 * h + 8 * ch; rk[i] = *(const u32x4*)src; rv[i] = *(const u32x4*)(src + 512); }
                    if (tid < 128) rc = cs2[(size_t)bh * SEQ + k0 + 128 + tid];
                }
                if (k0 <= rw0 + 31) {
                    FoxFn fn; fn.cs = csl; fn.key0 = k0 + 4 * g; fn.row0 = rw0 + li; fn.domask = (k0 + 127 > rw0);
                    attn_stage<4, 2, 4, 160, 160>(O, mrow, lsum, Qf, Ks, Vs, fn, lane);
                    if (k0 + 64 <= rw0 + 31) {
                        fn.cs = csl + 64; fn.key0 = k0 + 64 + 4 * g;
                        attn_stage<4, 2, 4, 160, 160>(O, mrow, lsum, Qf, Ks + 64 * 160, Vs + 64 * 160, fn, lane);
                    }
                }
            }
#pragma unroll
            for (int qt = 0; qt < 2; ++qt) {
                float l = lsum[qt]; l = quad_sum(l);
                const float inv = 1.0f / l;
                bf16_t* dst = Y + ((size_t)b * SEQ + rw0 + 16 * qt + li) * DM + 512 + 64 * h + 4 * g;
#pragma unroll
                for (int dt = 0; dt < 4; ++dt) { const f32x4 o = O[qt][dt] * inv; u32x2 w; w.x = pk2(o[0], o[1]); w.y = pk2(o[2], o[3]); *(u32x2*)(dst + 16 * dt) = w; }
            }
        }
    }
    __syncthreads();
}

struct BandFn {
    __device__ __forceinline__ f32x4 init(int) const { return (f32x4){0.f, 0.f, 0.f, 0.f}; }
    int jk0, jq, maxd; bool domask;
    __device__ __forceinline__ f32x4 apply(f32x4 s, int qt, int kt) const {
        f32x4 t = s;
        if (!domask) return t;
#pragma unroll
        for (int e = 0; e < 4; ++e) { const int jk = jk0 + 16 * kt + e, d = jq + 16 * qt - jk; if (jk < 0 || d < 0 || d > maxd) t[e] = -INFINITY; }
        return t;
    }
};

template <int QT>
__device__ __forceinline__ void band_job(const bf16_t* zb, int qcol, int kcol, int vcol, int dil, int r, int jq0, int maxd, int T0, bool first,
                                         LAS unsigned char* wl, LAS float* Ost, LAS float* mst, LAS float* lst, int lane) {
    const int li = lane & 15, g = lane >> 4, q4 = li >> 2, pp = li & 3;
    const int jks = jq0 + 16 * QT - 160;
    u32x4 rvA[4], rvB[4];
#define BAND_VLOAD(dst, s) do { _Pragma("unroll") for (int i = 0; i < 4; ++i) { const int pc = lane + 64 * i, row = pc >> 3, ch = pc & 7, jk = jks + 32 * (s) + row; \
        dst[i] = *(const u32x4*)(zb + (size_t)((jk < 0 ? 0 : jk) * dil + r) * CDN + vcol + 8 * ch); } } while (0)
#define BAND_VSTORE(src, s) do { LAS unsigned char* vb_ = wl + ((s) & 1) * 5120; _Pragma("unroll") for (int i = 0; i < 4; ++i) { const int pc = lane + 64 * i, row = pc >> 3, ch = pc & 7; *(LAS u32x4*)(vb_ + row * 160 + ch * 16) = src[i]; } } while (0)
    BAND_VLOAD(rvA, 0); BAND_VLOAD(rvB, 1);
    bf16x8 Qf[QT][2];
#pragma unroll
    for (int qt = 0; qt < QT; ++qt)
#pragma unroll
        for (int ks = 0; ks < 2; ++ks) Qf[qt][ks] = *(const bf16x8*)(zb + (size_t)((jq0 + 16 * qt + li) * dil + r) * CDN + qcol + 32 * ks + 8 * g);
    f32x4 S[QT][10];
#pragma unroll
    for (int half = 0; half < 2; ++half) {
        bf16x8 kf[5][2];
#pragma unroll
        for (int k5 = 0; k5 < 5; ++k5) {
            const int jk = jks + 16 * (5 * half + k5) + li;
#pragma unroll
            for (int ks = 0; ks < 2; ++ks) {
                kf[k5][ks] = *(const bf16x8*)(zb + (size_t)((jk < 0 ? 0 : jk) * dil + r) * CDN + kcol + 32 * ks + 8 * g);
            }
        }
#pragma unroll
        for (int k5 = 0; k5 < 5; ++k5)
#pragma unroll
            for (int qt = 0; qt < QT; ++qt) {
                f32x4 acc = (f32x4){0.f, 0.f, 0.f, 0.f};
#pragma unroll
                for (int ks = 0; ks < 2; ++ks) acc = __builtin_amdgcn_mfma_f32_16x16x32_bf16(kf[k5][ks], Qf[qt][ks], acc, 0, 0, 0);
                S[qt][5 * half + k5] = acc;
            }
    }
    const bool early = (jks < 0);
#pragma unroll
    for (int kt = 0; kt < 10; ++kt) {
        if (kt < 2 || kt >= 8 || early) {
#pragma unroll
            for (int qt = 0; qt < QT; ++qt)
#pragma unroll
                for (int e = 0; e < 4; ++e) { const int jk = jks + 16 * kt + 4 * g + e, d = jq0 + 16 * qt + li - jk; if (jk < 0 || d < 0 || d > maxd) S[qt][kt][e] = -INFINITY; }
        }
    }
    float mrow[QT], lsum[QT];
#pragma unroll
    for (int qt = 0; qt < QT; ++qt) {
        float mx = -INFINITY;
#pragma unroll
        for (int kt = 0; kt < 10; ++kt) { mx = max3f(mx, S[qt][kt][0], S[qt][kt][1]); mx = max3f(mx, S[qt][kt][2], S[qt][kt][3]); }
        mx = quad_max(mx);
        float ps = 0.f;
#pragma unroll
        for (int kt = 0; kt < 10; ++kt)
#pragma unroll
            for (int e = 0; e < 4; ++e) { const float pv = ex2(S[qt][kt][e] - mx); S[qt][kt][e] = pv; ps += pv; }
        mrow[qt] = mx; lsum[qt] = ps;
    }
    f32x4 O[QT][4];
#pragma unroll
    for (int qt = 0; qt < QT; ++qt)
#pragma unroll
        for (int dt = 0; dt < 4; ++dt) O[qt][dt] = (f32x4){0.f, 0.f, 0.f, 0.f};
#pragma unroll
    for (int s = 0; s < 5; ++s) {
        if (s & 1) BAND_VSTORE(rvB, s); else BAND_VSTORE(rvA, s);
        if (s + 2 < 5) { if (s & 1) BAND_VLOAD(rvB, s + 2); else BAND_VLOAD(rvA, s + 2); }
        bf16x8 Pf[QT];
#pragma unroll
        for (int qt = 0; qt < QT; ++qt) {
            u32x4 w; w.x = pk2(S[qt][2 * s][0], S[qt][2 * s][1]); w.y = pk2(S[qt][2 * s][2], S[qt][2 * s][3]);
            w.z = pk2(S[qt][2 * s + 1][0], S[qt][2 * s + 1][1]); w.w = pk2(S[qt][2 * s + 1][2], S[qt][2 * s + 1][3]);
            Pf[qt] = __builtin_bit_cast(bf16x8, w);
        }
        LAS const unsigned char* Vs = wl + (s & 1) * 5120;
#pragma unroll
        for (int dt = 0; dt < 4; ++dt) {
            LAS const unsigned char* vp = Vs + (4 * g + q4) * 160 + (16 * dt + 4 * pp) * 2;
            const s16x4 a1 = vtr(vp), a2 = vtr(vp + 16 * 160);
            const bf16x8 vf = (bf16x8){a1[0], a1[1], a1[2], a1[3], a2[0], a2[1], a2[2], a2[3]};
#pragma unroll
            for (int qt = 0; qt < QT; ++qt) O[qt][dt] = __builtin_amdgcn_mfma_f32_16x16x32_bf16(vf, Pf[qt], O[qt][dt], 0, 0, 0);
        }
    }
#undef BAND_VLOAD
#undef BAND_VSTORE
#pragma unroll
    for (int qt = 0; qt < QT; ++qt) {
        float l = lsum[qt]; l = quad_sum(l);
        const int tl = (jq0 + 16 * qt + li) * dil + r - T0;
        float fo = 0.f, fn_ = 1.f, mn = mrow[qt], ln = l;
        if (!first) { const float mo = mst[tl], lo = lst[tl]; mn = fmaxf(mo, mrow[qt]); fo = ex2(mo - mn); fn_ = ex2(mrow[qt] - mn); ln = lo * fo + l * fn_; }
#pragma unroll
        for (int dt = 0; dt < 4; ++dt) {
            LAS f32x4* sp = (LAS f32x4*)(Ost + tl * 64 + 16 * dt + 4 * g);
            f32x4 o = O[qt][dt] * fn_;
            if (!first) o = o + (*sp) * fo;
            *sp = o;
        }
        if (g == 0) { mst[tl] = mn; lst[tl] = ln; }
    }
}

__device__ __forceinline__ const bf16_t* zhead(const bf16_t* Z, int b, int hb) { return Z + ((size_t)(b * 36 + hb) * SEQ) * 64; }
constexpr size_t WS_P16 = WS_R1 + 320 * MiB;
constexpr size_t WS_M16 = WS_R1 + 400 * MiB;
constexpr size_t WS_L16 = WS_R1 + 404 * MiB;
__device__ __forceinline__ void d16_job(LAS const unsigned char* Kc, LAS const unsigned char* Vc, const bf16_t* qh, int r, int qt, bf16_t* Pb, float* Mb, float* Lb, int lane) {
    const int li = lane & 15, g = lane >> 4, q4 = li >> 2, pp = li & 3;
    const int token = (16 * qt + li) * 16 + r;
    bf16x8 Qf[2];
#pragma unroll
    for (int ks = 0; ks < 2; ++ks) Qf[ks] = *(const bf16x8*)(qh + (unsigned)(token * 64 + 32 * ks + 8 * g));
    bf16x8 kf[8][2];
    LAS const unsigned char* kbase = Kc + li * 160 + 16 * g;
#pragma unroll
    for (int kt = 0; kt < 8; ++kt)
#pragma unroll
        for (int ks = 0; ks < 2; ++ks) kf[kt][ks] = *(LAS const bf16x8*)(kbase + (16 * kt) * 160 + 64 * ks);
    __builtin_amdgcn_sched_barrier(0);
    f32x4 S[8];
#pragma unroll
    for (int kt = 0; kt < 8; ++kt) {
        f32x4 acc = (f32x4){0.f, 0.f, 0.f, 0.f};
#pragma unroll
        for (int ks = 0; ks < 2; ++ks) acc = __builtin_amdgcn_mfma_f32_16x16x32_bf16(kf[kt][ks], Qf[ks], acc, 0, 0, 0);
        S[kt] = acc;
    }
    float mx = -INFINITY;
#pragma unroll
    for (int kt = 0; kt < 8; ++kt) {
#pragma unroll
        for (int e = 0; e < 4; ++e) if (16 * kt + 4 * g + e > 16 * qt + li) S[kt][e] = -INFINITY;
        mx = max3f(mx, S[kt][0], S[kt][1]); mx = max3f(mx, S[kt][2], S[kt][3]);
    }
    mx = quad_max(mx);
    float ps = 0.f;
#pragma unroll
    for (int kt = 0; kt < 8; ++kt)
#pragma unroll
        for (int e = 0; e < 4; ++e) { const float pv = ex2(S[kt][e] - mx); S[kt][e] = pv; ps += pv; }
    const float l = quad_sum(ps);
    f32x4 O[4];
#pragma unroll
    for (int dt = 0; dt < 4; ++dt) O[dt] = (f32x4){0.f, 0.f, 0.f, 0.f};
    LAS const unsigned char* vbase = Vc + (4 * g + q4) * 160 + 8 * pp;
#pragma unroll
    for (int s = 0; s < 4; ++s) {
        s16x4 va[4][2];
#pragma unroll
        for (int dt = 0; dt < 4; ++dt) { va[dt][0] = vtr(vbase + (32 * s) * 160 + 32 * dt); va[dt][1] = vtr(vbase + (32 * s + 16) * 160 + 32 * dt); }
        u32x4 w; w.x = pk2(S[2 * s][0], S[2 * s][1]); w.y = pk2(S[2 * s][2], S[2 * s][3]); w.z = pk2(S[2 * s + 1][0], S[2 * s + 1][1]); w.w = pk2(S[2 * s + 1][2], S[2 * s + 1][3]);
        const bf16x8 Pf = __builtin_bit_cast(bf16x8, w);
#pragma unroll
        for (int dt = 0; dt < 4; ++dt) {
            const bf16x8 vf = (bf16x8){va[dt][0][0], va[dt][0][1], va[dt][0][2], va[dt][0][3], va[dt][1][0], va[dt][1][1], va[dt][1][2], va[dt][1][3]};
            O[dt] = __builtin_amdgcn_mfma_f32_16x16x32_bf16(vf, Pf, O[dt], 0, 0, 0);
        }
    }
    const float inv = 1.0f / l;
    bf16_t* dst = Pb + (size_t)token * 512 + 4 * g;
#pragma unroll
    for (int dt = 0; dt < 4; ++dt) { const f32x4 o = O[dt] * inv; u32x2 w2; w2.x = pk2(o[0], o[1]); w2.y = pk2(o[2], o[3]); *(u32x2*)(dst + 16 * dt) = w2; }
    if (g == 0) { Mb[(size_t)token * 8] = mx; Lb[(size_t)token * 8] = l; }
}
__device__ __forceinline__ void d16_phase(const Params& p, LAS unsigned char* lds) {
    int tid_l = threadIdx.x; asm volatile("" : "+v"(tid_l)); const int tid = tid_l, lane = tid & 63, wid = __builtin_amdgcn_readfirstlane(tid >> 6);
    const bf16_t* Z = (const bf16_t*)(p.ws + WS_R1);
    LAS unsigned char* Ks = lds;
    LAS unsigned char* Vs = lds + 40960;
    for (int bh = blockIdx.x; bh < NB * 8; bh += gridDim.x) {
        const int b = bh >> 3, h = bh & 7;
        const bf16_t* qh = zhead(Z, b, h); const bf16_t* kh_ = zhead(Z, b, 8 + h); const bf16_t* vh_ = zhead(Z, b, 16 + h);
        bf16_t* Pb = (bf16_t*)(p.ws + WS_P16) + (size_t)b * SEQ * 512 + 64 * h;
        float* Mb = (float*)(p.ws + WS_M16) + (size_t)b * SEQ * 8 + h;
        float* Lb = (float*)(p.ws + WS_L16) + (size_t)b * SEQ * 8 + h;
        u32x4 rk[4], rv[4];
#define D16_LOAD(cp) do { _Pragma("unroll") for (int i = 0; i < 4; ++i) { const int c = tid + 512 * i, row = c >> 3, ch = c & 7, token = (row & 127) * 16 + 2 * (cp) + (row >> 7); \
            const unsigned so = (unsigned)(token * 64 + 8 * ch); rk[i] = *(const u32x4*)(kh_ + so); rv[i] = *(const u32x4*)(vh_ + so); } } while (0)
        D16_LOAD(0);
        for (int cp = 0; cp < 8; ++cp) {
            __syncthreads();
#pragma unroll
            for (int i = 0; i < 4; ++i) { const int c = tid + 512 * i, row = c >> 3, ch = c & 7; *(LAS u32x4*)(Ks + row * 160 + ch * 16) = rk[i]; *(LAS u32x4*)(Vs + row * 160 + ch * 16) = rv[i]; }
            __syncthreads();
            if (cp + 1 < 8) D16_LOAD(cp + 1);
            d16_job(Ks, Vs, qh, 2 * cp, wid, Pb, Mb, Lb, lane);
            d16_job(Ks + 128 * 160, Vs + 128 * 160, qh, 2 * cp + 1, 7 - wid, Pb, Mb, Lb, lane);
        }
#undef D16_LOAD
    }
    __syncthreads();
}

__device__ __forceinline__ void swa_phase(const Params& p, LAS unsigned char* lds) {
    int tid_l = threadIdx.x; asm volatile("" : "+v"(tid_l)); const int tid = tid_l, lane = tid & 63, wid = __builtin_amdgcn_readfirstlane(tid >> 6), li = lane & 15, g = lane >> 4, q4 = li >> 2, pp = li & 3;
    const bf16_t* Z = (const bf16_t*)(p.ws + WS_R1);
    bf16_t* Y = (bf16_t*)(p.ws + WS_Y);
    LAS unsigned char* Ks = lds;
    LAS unsigned char* Vs = lds + 61440;
    const int vcu = __builtin_amdgcn_readfirstlane(*(volatile LAS int*)(lds + LDS_BYTES - 48));
    for (int unit = blockIdx.x; unit < NB * 8 * 2; unit += gridDim.x) {
        int u2 = unit;
        if (gridDim.x == 256) { const int x = vcu & 7, v = vcu >> 3, i = unit >> 8; u2 = ((x * 4 + (v >> 3)) * 8 + (v & 7)) * 2 + i; }
        const int kvh = u2 & 1, bt = u2 >> 1, b = bt >> 3, tb = bt & 7, T0 = tb * 256;
        const bf16_t* kh_ = zhead(Z, b, 32 + kvh); const bf16_t* vh_ = zhead(Z, b, 34 + kvh);
        {
            u32x4 rk[6], rv[6];
#pragma unroll
            for (int k = 0; k < 6; ++k) {
                int tok = T0 - 128 + (tid >> 3) + 64 * k; tok = tok < 0 ? 0 : tok;
                const unsigned so = (unsigned)(tok * 64 + 8 * (tid & 7));
                rk[k] = *(const u32x4*)(kh_ + so); rv[k] = *(const u32x4*)(vh_ + so);
            }
            __syncthreads();
            LAS unsigned char* lp = Ks + (tid >> 3) * 160 + (tid & 7) * 16;
#pragma unroll
            for (int k = 0; k < 6; ++k) { *(LAS u32x4*)(lp + 64 * 160 * k) = rk[k]; *(LAS u32x4*)(lp + 61440 + 64 * 160 * k) = rv[k]; }
            __syncthreads();
        }
        const bool early = (T0 == 0);
        LAS const unsigned char* kbase = Ks + (32 * wid + li) * 160 + 16 * g;
        LAS const unsigned char* vbase = Vs + (32 * wid + 4 * g + q4) * 160 + 8 * pp;
        for (int qh = 0; qh < 4; ++qh) {
            const int h8 = 4 * kvh + qh;
            const bf16_t* qb_ = zhead(Z, b, 24 + h8) + (T0 + 32 * wid) * 64;
            bf16x8 Qf[2][2];
#pragma unroll
            for (int qt = 0; qt < 2; ++qt)
#pragma unroll
                for (int ks = 0; ks < 2; ++ks) Qf[qt][ks] = *(const bf16x8*)(qb_ + (unsigned)((16 * qt + li) * 64 + 32 * ks + 8 * g));
            f32x4 S[2][10];
            {
                bf16x8 kf[2][2][2];
#pragma unroll
                for (int t = 0; t < 2; ++t)
#pragma unroll
                    for (int ks = 0; ks < 2; ++ks) kf[0][t][ks] = *(LAS const bf16x8*)(kbase + (16 * t) * 160 + 64 * ks);
#pragma unroll
                for (int kb = 0; kb < 5; ++kb) {
                    if (kb + 1 < 5) {
#pragma unroll
                        for (int t = 0; t < 2; ++t)
#pragma unroll
                            for (int ks = 0; ks < 2; ++ks) kf[(kb + 1) & 1][t][ks] = *(LAS const bf16x8*)(kbase + (16 * (2 * (kb + 1) + t)) * 160 + 64 * ks);
                    }
                    __builtin_amdgcn_sched_barrier(0); __builtin_amdgcn_s_setprio(1);
#pragma unroll
                    for (int t = 0; t < 2; ++t)
#pragma unroll
                        for (int qt = 0; qt < 2; ++qt) {
                            f32x4 acc = (f32x4){0.f, 0.f, 0.f, 0.f};
#pragma unroll
                            for (int ks = 0; ks < 2; ++ks) acc = __builtin_amdgcn_mfma_f32_16x16x32_bf16(kf[kb & 1][t][ks], Qf[qt][ks], acc, 0, 0, 0);
                            S[qt][2 * kb + t] = acc;
                        }
__builtin_amdgcn_s_setprio(0); __builtin_amdgcn_sched_barrier(0);
                }
            }
#pragma unroll
            for (int kt = 0; kt < 10; ++kt) {
                if (kt < 2 || kt >= 8 || early) {
#pragma unroll
                    for (int qt = 0; qt < 2; ++qt)
#pragma unroll
                        for (int e = 0; e < 4; ++e) { const int kr = 16 * kt + 4 * g + e - 128, d = 16 * qt + li - kr; if (d < 0 || d > 127 || T0 + 32 * wid + kr < 0) S[qt][kt][e] = -INFINITY; }
                }
            }
            const float sink2 = p.in[15][h8] * LOG2E;
            float scl[2];
            bf16x8 Pf[2][5];
#pragma unroll
            for (int qt = 0; qt < 2; ++qt) {
                float mx = -INFINITY;
#pragma unroll
                for (int kt = 0; kt < 10; ++kt) { mx = max3f(mx, S[qt][kt][0], S[qt][kt][1]); mx = max3f(mx, S[qt][kt][2], S[qt][kt][3]); }
                mx = max2f(quad_max(mx), sink2);
                float ps = 0.f;
#pragma unroll
                for (int kt = 0; kt < 10; ++kt)
#pragma unroll
                    for (int e = 0; e < 4; ++e) { const float pv = ex2(S[qt][kt][e] - mx); S[qt][kt][e] = pv; ps += pv; }
                scl[qt] = 1.0f / (quad_sum(ps) + ex2(sink2 - mx));
#pragma unroll
                for (int s = 0; s < 5; ++s) {
                    u32x4 w; w.x = pk2(S[qt][2 * s][0], S[qt][2 * s][1]); w.y = pk2(S[qt][2 * s][2], S[qt][2 * s][3]);
                    w.z = pk2(S[qt][2 * s + 1][0], S[qt][2 * s + 1][1]); w.w = pk2(S[qt][2 * s + 1][2], S[qt][2 * s + 1][3]);
                    Pf[qt][s] = __builtin_bit_cast(bf16x8, w);
                }
            }
            f32x4 O[2][4];
#pragma unroll
            for (int qt = 0; qt < 2; ++qt)
#pragma unroll
                for (int dt = 0; dt < 4; ++dt) O[qt][dt] = (f32x4){0.f, 0.f, 0.f, 0.f};
            {
                s16x4 va[2][4][2];
#pragma unroll
                for (int dt = 0; dt < 4; ++dt) { va[0][dt][0] = vtr(vbase + 32 * dt); va[0][dt][1] = vtr(vbase + 16 * 160 + 32 * dt); }
#pragma unroll
                for (int s = 0; s < 5; ++s) {
                    if (s + 1 < 5) {
#pragma unroll
                        for (int dt = 0; dt < 4; ++dt) { va[(s + 1) & 1][dt][0] = vtr(vbase + (32 * (s + 1)) * 160 + 32 * dt); va[(s + 1) & 1][dt][1] = vtr(vbase + (32 * (s + 1) + 16) * 160 + 32 * dt); }
                    }
                    __builtin_amdgcn_sched_barrier(0); __builtin_amdgcn_s_setprio(1);
#pragma unroll
                    for (int dt = 0; dt < 4; ++dt) {
                        const s16x4 a1 = va[s & 1][dt][0], a2 = va[s & 1][dt][1];
                        const bf16x8 vf = (bf16x8){a1[0], a1[1], a1[2], a1[3], a2[0], a2[1], a2[2], a2[3]};
#pragma unroll
                        for (int qt = 0; qt < 2; ++qt) O[qt][dt] = __builtin_amdgcn_mfma_f32_16x16x32_bf16(vf, Pf[qt][s], O[qt][dt], 0, 0, 0);
                    }
__builtin_amdgcn_s_setprio(0); __builtin_amdgcn_sched_barrier(0);
                }
            }
            bf16_t* yb_ = Y + ((size_t)b * SEQ + T0 + 32 * wid) * DM + 512 + 64 * h8;
#pragma unroll
            for (int qt = 0; qt < 2; ++qt)
#pragma unroll
                for (int dt = 0; dt < 4; ++dt) { const f32x4 o = O[qt][dt] * scl[qt]; u32x2 w; w.x = pk2(o[0], o[1]); w.y = pk2(o[2], o[3]); *(u32x2*)(yb_ + (unsigned)((16 * qt + li) * DM + 16 * dt + 4 * g)) = w; }
        }
    }
    __syncthreads();
}

constexpr size_t WS_P4 = WS_R1 + 408 * MiB, WS_M4 = WS_R1 + 480 * MiB, WS_L4 = WS_R1 + 484 * MiB;
__device__ __forceinline__ void d4_phase(const Params& p, LAS unsigned char* lds) {
    int tid_l = threadIdx.x; asm volatile("" : "+v"(tid_l)); const int tid = tid_l, lane = tid & 63, wid = __builtin_amdgcn_readfirstlane(tid >> 6), li = lane & 15, g = lane >> 4, q4 = li >> 2, pp = li & 3;
    const bf16_t* Z = (const bf16_t*)(p.ws + WS_R1);
    LAS unsigned char* Ks = lds;
    LAS unsigned char* Vs = lds + 61440;
    const int vcu = __builtin_amdgcn_readfirstlane(*(volatile LAS int*)(lds + LDS_BYTES - 48));
#define D4_PARAMS(u_, b_, hq_, r4_, T0_) int b_, hq_, r4_, T0_; { int bh_ = (u_) >> 3, sub_ = (u_) & 7; if (gridDim.x == 256) { bh_ = (vcu & 7) * 32 + (vcu >> 3); sub_ = (u_) >> 8; } \
        b_ = bh_ >> 3; hq_ = bh_ & 7; r4_ = sub_ >> 1; T0_ = (sub_ & 1) * 256; }
    u32x4 rk[6], rv[6]; bf16x8 Qn[2][2];
#define D4_FETCH(u_) do { D4_PARAMS(u_, fb, fh, fr, fT); const bf16_t* kh_ = zhead(Z, fb, 8 + fh); const bf16_t* vh_ = zhead(Z, fb, 16 + fh); \
        _Pragma("unroll") for (int k = 0; k < 6; ++k) { int j = fT - 128 + (tid >> 3) + 64 * k; j = j < 0 ? 0 : j; const unsigned so = (unsigned)((4 * j + fr) * 64 + 8 * (tid & 7)); \
            rk[k] = *(const u32x4*)(kh_ + so); rv[k] = *(const u32x4*)(vh_ + so); } \
        const bf16_t* qb_ = zhead(Z, fb, fh) + (4 * (fT + 32 * wid) + fr) * 64; \
        _Pragma("unroll") for (int qt = 0; qt < 2; ++qt) _Pragma("unroll") for (int ks = 0; ks < 2; ++ks) Qn[qt][ks] = *(const bf16x8*)(qb_ + (unsigned)(4 * (16 * qt + li) * 64 + 32 * ks + 8 * g)); } while (0)
    const int nunits = NB * 8 * 8;
    if ((int)blockIdx.x < nunits) D4_FETCH((int)blockIdx.x);
    for (int unit = blockIdx.x; unit < nunits; unit += gridDim.x) {
        D4_PARAMS(unit, b, hq, r4, T0);
        __syncthreads();
        {
            LAS unsigned char* lp = Ks + (tid >> 3) * 160 + (tid & 7) * 16;
#pragma unroll
            for (int k = 0; k < 6; ++k) { *(LAS u32x4*)(lp + 64 * 160 * k) = rk[k]; *(LAS u32x4*)(lp + 61440 + 64 * 160 * k) = rv[k]; }
        }
        bf16x8 Qf[2][2];
#pragma unroll
        for (int qt = 0; qt < 2; ++qt)
#pragma unroll
            for (int ks = 0; ks < 2; ++ks) Qf[qt][ks] = Qn[qt][ks];
        __syncthreads();
        if (unit + (int)gridDim.x < nunits) D4_FETCH(unit + (int)gridDim.x);
        const bool early = (T0 == 0);
        LAS const unsigned char* kbase = Ks + (32 * wid + li) * 160 + 16 * g;
        LAS const unsigned char* vbase = Vs + (32 * wid + 4 * g + q4) * 160 + 8 * pp;
        for (int once = 0; once < 1; ++once) {
            f32x4 S[2][10];
            {
                bf16x8 kf[2][2][2];
#pragma unroll
                for (int t = 0; t < 2; ++t)
#pragma unroll
                    for (int ks = 0; ks < 2; ++ks) kf[0][t][ks] = *(LAS const bf16x8*)(kbase + (16 * t) * 160 + 64 * ks);
#pragma unroll
                for (int kb = 0; kb < 5; ++kb) {
                    if (kb + 1 < 5) {
#pragma unroll
                        for (int t = 0; t < 2; ++t)
#pragma unroll
                            for (int ks = 0; ks < 2; ++ks) kf[(kb + 1) & 1][t][ks] = *(LAS const bf16x8*)(kbase + (16 * (2 * (kb + 1) + t)) * 160 + 64 * ks);
                    }
                    __builtin_amdgcn_sched_barrier(0); __builtin_amdgcn_s_setprio(1);
#pragma unroll
                    for (int t = 0; t < 2; ++t)
#pragma unroll
                        for (int qt = 0; qt < 2; ++qt) {
                            f32x4 acc = (f32x4){0.f, 0.f, 0.f, 0.f};
#pragma unroll
                            for (int ks = 0; ks < 2; ++ks) acc = __builtin_amdgcn_mfma_f32_16x16x32_bf16(kf[kb & 1][t][ks], Qf[qt][ks], acc, 0, 0, 0);
                            S[qt][2 * kb + t] = acc;
                        }
__builtin_amdgcn_s_setprio(0); __builtin_amdgcn_sched_barrier(0);
                }
            }
#pragma unroll
            for (int kt = 0; kt < 10; ++kt) {
                if (kt < 2 || kt >= 8 || early) {
#pragma unroll
                    for (int qt = 0; qt < 2; ++qt)
#pragma unroll
                        for (int e = 0; e < 4; ++e) { const int kr = 16 * kt + 4 * g + e - 128, d = 16 * qt + li - kr; if (d < 0 || d > 128 || T0 + 32 * wid + kr < 0) S[qt][kt][e] = -INFINITY; }
                }
            }
            float scl[2], mq[2], lq[2];
            bf16x8 Pf[2][5];
#pragma unroll
            for (int qt = 0; qt < 2; ++qt) {
                float mx = -INFINITY;
#pragma unroll
                for (int kt = 0; kt < 10; ++kt) { mx = max3f(mx, S[qt][kt][0], S[qt][kt][1]); mx = max3f(mx, S[qt][kt][2], S[qt][kt][3]); }
                mx = quad_max(mx);
                float ps = 0.f;
#pragma unroll
                for (int kt = 0; kt < 10; ++kt)
#pragma unroll
                    for (int e = 0; e < 4; ++e) { const float pv = ex2(S[qt][kt][e] - mx); S[qt][kt][e] = pv; ps += pv; }
                lq[qt] = quad_sum(ps); mq[qt] = mx; scl[qt] = 1.0f / lq[qt];
#pragma unroll
                for (int s = 0; s < 5; ++s) {
                    u32x4 w; w.x = pk2(S[qt][2 * s][0], S[qt][2 * s][1]); w.y = pk2(S[qt][2 * s][2], S[qt][2 * s][3]);
                    w.z = pk2(S[qt][2 * s + 1][0], S[qt][2 * s + 1][1]); w.w = pk2(S[qt][2 * s + 1][2], S[qt][2 * s + 1][3]);
                    Pf[qt][s] = __builtin_bit_cast(bf16x8, w);
                }
            }
            f32x4 O[2][4];
#pragma unroll
            for (int qt = 0; qt < 2; ++qt)
#pragma unroll
                for (int dt = 0; dt < 4; ++dt) O[qt][dt] = (f32x4){0.f, 0.f, 0.f, 0.f};
            {
                s16x4 va[2][4][2];
#pragma unroll
                for (int dt = 0; dt < 4; ++dt) { va[0][dt][0] = vtr(vbase + 32 * dt); va[0][dt][1] = vtr(vbase + 16 * 160 + 32 * dt); }
#pragma unroll
                for (int s = 0; s < 5; ++s) {
                    if (s + 1 < 5) {
#pragma unroll
                        for (int dt = 0; dt < 4; ++dt) { va[(s + 1) & 1][dt][0] = vtr(vbase + (32 * (s + 1)) * 160 + 32 * dt); va[(s + 1) & 1][dt][1] = vtr(vbase + (32 * (s + 1) + 16) * 160 + 32 * dt); }
                    }
                    __builtin_amdgcn_sched_barrier(0); __builtin_amdgcn_s_setprio(1);
#pragma unroll
                    for (int dt = 0; dt < 4; ++dt) {
                        const s16x4 a1 = va[s & 1][dt][0], a2 = va[s & 1][dt][1];
                        const bf16x8 vf = (bf16x8){a1[0], a1[1], a1[2], a1[3], a2[0], a2[1], a2[2], a2[3]};
#pragma unroll
                        for (int qt = 0; qt < 2; ++qt) O[qt][dt] = __builtin_amdgcn_mfma_f32_16x16x32_bf16(vf, Pf[qt][s], O[qt][dt], 0, 0, 0);
                    }
__builtin_amdgcn_s_setprio(0); __builtin_amdgcn_sched_barrier(0);
                }
            }
#pragma unroll
            for (int qt = 0; qt < 2; ++qt) {
                const size_t trow = (size_t)b * SEQ + 4 * (T0 + 32 * wid + 16 * qt + li) + r4;
                bf16_t* dst = (bf16_t*)(p.ws + WS_P4) + trow * 512 + 64 * hq + 4 * g;
#pragma unroll
                for (int dt = 0; dt < 4; ++dt) { const f32x4 o = O[qt][dt] * scl[qt]; u32x2 w; w.x = pk2(o[0], o[1]); w.y = pk2(o[2], o[3]); *(u32x2*)(dst + 16 * dt) = w; }
                if (g == 0) { ((float*)(p.ws + WS_M4))[trow * 8 + hq] = mq[qt]; ((float*)(p.ws + WS_L4))[trow * 8 + hq] = lq[qt]; }
            }
        }
    }
#undef D4_PARAMS
#undef D4_FETCH
    __syncthreads();
}

__device__ __forceinline__ void band_phase(const Params& p, LAS unsigned char* lds) {
    int tid_l = threadIdx.x; asm volatile("" : "+v"(tid_l)); const int tid = tid_l, lane = tid & 63, wid = __builtin_amdgcn_readfirstlane(tid >> 6), li = lane & 15, g = lane >> 4, q4 = li >> 2, pp = li & 3;
    const bf16_t* Z = (const bf16_t*)(p.ws + WS_R1);
    bf16_t* Y = (bf16_t*)(p.ws + WS_Y);
    LAS unsigned char* Ks = lds;
    LAS unsigned char* Vs = lds + 61440;
    const int vcu = __builtin_amdgcn_readfirstlane(*(volatile LAS int*)(lds + LDS_BYTES - 48));
#define BD_PARAMS(u_, b_, hq_, r4_, T0_) int b_, hq_, r4_, T0_; { int bt_ = (u_) >> 3; hq_ = (u_) & 7; if (gridDim.x == 256) { const int v_ = vcu >> 3; bt_ = ((vcu & 7) * 4 + (v_ >> 3)) * 8 + (v_ & 7); hq_ = (u_) >> 8; } \
        b_ = bt_ >> 3; r4_ = 0; T0_ = (bt_ & 7) * 256; }
    u32x4 rk[6], rv[6]; bf16x8 Qn[2][2];
#define BD_FETCH(u_) do { BD_PARAMS(u_, fb, fh, fr, fT); const bf16_t* kh_ = zhead(Z, fb, 8 + fh); const bf16_t* vh_ = zhead(Z, fb, 16 + fh); \
        _Pragma("unroll") for (int k = 0; k < 6; ++k) { int j = fT - 128 + (tid >> 3) + 64 * k; j = j < 0 ? 0 : j; const unsigned so = (unsigned)(j * 64 + 8 * (tid & 7)); \
            rk[k] = *(const u32x4*)(kh_ + so); rv[k] = *(const u32x4*)(vh_ + so); } \
        const bf16_t* qb_ = zhead(Z, fb, fh) + (fT + 32 * wid) * 64; \
        _Pragma("unroll") for (int qt = 0; qt < 2; ++qt) _Pragma("unroll") for (int ks = 0; ks < 2; ++ks) Qn[qt][ks] = *(const bf16x8*)(qb_ + (unsigned)((16 * qt + li) * 64 + 32 * ks + 8 * g)); } while (0)
    const int nunits = NB * 8 * 8;
    if ((int)blockIdx.x < nunits) BD_FETCH((int)blockIdx.x);
    for (int unit = blockIdx.x; unit < nunits; unit += gridDim.x) {
        BD_PARAMS(unit, b, hq, r4, T0);
        __syncthreads();
        {
            LAS unsigned char* lp = Ks + (tid >> 3) * 160 + (tid & 7) * 16;
#pragma unroll
            for (int k = 0; k < 6; ++k) { *(LAS u32x4*)(lp + 64 * 160 * k) = rk[k]; *(LAS u32x4*)(lp + 61440 + 64 * 160 * k) = rv[k]; }
        }
        bf16x8 Qf[2][2];
#pragma unroll
        for (int qt = 0; qt < 2; ++qt)
#pragma unroll
            for (int ks = 0; ks < 2; ++ks) Qf[qt][ks] = Qn[qt][ks];
        __syncthreads();
        if (unit + (int)gridDim.x < nunits) BD_FETCH(unit + (int)gridDim.x);
        const bool early = (T0 == 0);
        LAS const unsigned char* kbase = Ks + (32 * wid + li) * 160 + 16 * g;
        LAS const unsigned char* vbase = Vs + (32 * wid + 4 * g + q4) * 160 + 8 * pp;
        for (int once = 0; once < 1; ++once) {
            f32x4 S[2][10];
            {
                bf16x8 kf[2][2][2];
#pragma unroll
                for (int t = 0; t < 2; ++t)
#pragma unroll
                    for (int ks = 0; ks < 2; ++ks) kf[0][t][ks] = *(LAS const bf16x8*)(kbase + (16 * t) * 160 + 64 * ks);
#pragma unroll
                for (int kb = 0; kb < 5; ++kb) {
                    if (kb + 1 < 5) {
#pragma unroll
                        for (int t = 0; t < 2; ++t)
#pragma unroll
                            for (int ks = 0; ks < 2; ++ks) kf[(kb + 1) & 1][t][ks] = *(LAS const bf16x8*)(kbase + (16 * (2 * (kb + 1) + t)) * 160 + 64 * ks);
                    }
                    __builtin_amdgcn_sched_barrier(0); __builtin_amdgcn_s_setprio(1);
#pragma unroll
                    for (int t = 0; t < 2; ++t)
#pragma unroll
                        for (int qt = 0; qt < 2; ++qt) {
                            f32x4 acc = (f32x4){0.f, 0.f, 0.f, 0.f};
#pragma unroll
                            for (int ks = 0; ks < 2; ++ks) acc = __builtin_amdgcn_mfma_f32_16x16x32_bf16(kf[kb & 1][t][ks], Qf[qt][ks], acc, 0, 0, 0);
                            S[qt][2 * kb + t] = acc;
                        }
__builtin_amdgcn_s_setprio(0); __builtin_amdgcn_sched_barrier(0);
                }
            }
#pragma unroll
            for (int kt = 0; kt < 10; ++kt) {
                if (kt < 2 || kt >= 8 || early) {
#pragma unroll
                    for (int qt = 0; qt < 2; ++qt)
#pragma unroll
                        for (int e = 0; e < 4; ++e) { const int kr = 16 * kt + 4 * g + e - 128, d = 16 * qt + li - kr; if (d < 0 || d > 128 || T0 + 32 * wid + kr < 0) S[qt][kt][e] = -INFINITY; }
                }
            }
            float scl[2], mq[2], lq[2];
            bf16x8 Pf[2][5];
#pragma unroll
            for (int qt = 0; qt < 2; ++qt) {
                float mx = -INFINITY;
#pragma unroll
                for (int kt = 0; kt < 10; ++kt) { mx = max3f(mx, S[qt][kt][0], S[qt][kt][1]); mx = max3f(mx, S[qt][kt][2], S[qt][kt][3]); }
                mx = quad_max(mx);
                float ps = 0.f;
#pragma unroll
                for (int kt = 0; kt < 10; ++kt)
#pragma unroll
                    for (int e = 0; e < 4; ++e) { const float pv = ex2(S[qt][kt][e] - mx); S[qt][kt][e] = pv; ps += pv; }
                lq[qt] = quad_sum(ps); mq[qt] = mx; scl[qt] = 1.0f / lq[qt];
#pragma unroll
                for (int s = 0; s < 5; ++s) {
                    u32x4 w; w.x = pk2(S[qt][2 * s][0], S[qt][2 * s][1]); w.y = pk2(S[qt][2 * s][2], S[qt][2 * s][3]);
                    w.z = pk2(S[qt][2 * s + 1][0], S[qt][2 * s + 1][1]); w.w = pk2(S[qt][2 * s + 1][2], S[qt][2 * s + 1][3]);
                    Pf[qt][s] = __builtin_bit_cast(bf16x8, w);
                }
            }
            f32x4 O[2][4];
#pragma unroll
            for (int qt = 0; qt < 2; ++qt)
#pragma unroll
                for (int dt = 0; dt < 4; ++dt) O[qt][dt] = (f32x4){0.f, 0.f, 0.f, 0.f};
            {
                s16x4 va[2][4][2];
#pragma unroll
                for (int dt = 0; dt < 4; ++dt) { va[0][dt][0] = vtr(vbase + 32 * dt); va[0][dt][1] = vtr(vbase + 16 * 160 + 32 * dt); }
#pragma unroll
                for (int s = 0; s < 5; ++s) {
                    if (s + 1 < 5) {
#pragma unroll
                        for (int dt = 0; dt < 4; ++dt) { va[(s + 1) & 1][dt][0] = vtr(vbase + (32 * (s + 1)) * 160 + 32 * dt); va[(s + 1) & 1][dt][1] = vtr(vbase + (32 * (s + 1) + 16) * 160 + 32 * dt); }
                    }
                    __builtin_amdgcn_sched_barrier(0); __builtin_amdgcn_s_setprio(1);
#pragma unroll
                    for (int dt = 0; dt < 4; ++dt) {
                        const s16x4 a1 = va[s & 1][dt][0], a2 = va[s & 1][dt][1];
                        const bf16x8 vf = (bf16x8){a1[0], a1[1], a1[2], a1[3], a2[0], a2[1], a2[2], a2[3]};
#pragma unroll
                        for (int qt = 0; qt < 2; ++qt) O[qt][dt] = __builtin_amdgcn_mfma_f32_16x16x32_bf16(vf, Pf[qt][s], O[qt][dt], 0, 0, 0);
                    }
__builtin_amdgcn_s_setprio(0); __builtin_amdgcn_sched_barrier(0);
                }
            }
#pragma unroll
                for (int qt = 0; qt < 2; ++qt) {
                    const int tl = 32 * wid + 16 * qt + li;
                    const size_t trow = (size_t)b * SEQ + T0 + tl;
                    const float l16 = ((const float*)(p.ws + WS_L16))[trow * 8 + hq], m16 = ((const float*)(p.ws + WS_M16))[trow * 8 + hq];
                    const float l4 = ((const float*)(p.ws + WS_L4))[trow * 8 + hq], m4 = ((const float*)(p.ws + WS_M4))[trow * 8 + hq];
                    const bf16_t* s16 = (const bf16_t*)(p.ws + WS_P16) + trow * 512 + 64 * hq + 4 * g;
                    const bf16_t* s4 = (const bf16_t*)(p.ws + WS_P4) + trow * 512 + 64 * hq + 4 * g;
                    const float mn = max3f(m16, m4, mq[qt]);
                    const float f16 = ex2(m16 - mn) * l16, f4 = ex2(m4 - mn) * l4, f1 = ex2(mq[qt] - mn);
                    const float inv = 1.0f / (f16 + f4 + lq[qt] * f1);
                    bf16_t* dst = Y + trow * DM + 64 * hq + 4 * g;
#pragma unroll
                    for (int dt = 0; dt < 4; ++dt) {
                        const u32x2 pa = *(const u32x2*)(s16 + 16 * dt), pb = *(const u32x2*)(s4 + 16 * dt);
                        f32x4 o = O[qt][dt] * f1;
                        o[0] += __uint_as_float(pa.x << 16) * f16 + __uint_as_float(pb.x << 16) * f4; o[1] += __uint_as_float(pa.x & 0xffff0000u) * f16 + __uint_as_float(pb.x & 0xffff0000u) * f4;
                        o[2] += __uint_as_float(pa.y << 16) * f16 + __uint_as_float(pb.y << 16) * f4; o[3] += __uint_as_float(pa.y & 0xffff0000u) * f16 + __uint_as_float(pb.y & 0xffff0000u) * f4;
                        o = o * inv;
                        u32x2 w; w.x = pk2(o[0], o[1]); w.y = pk2(o[2], o[3]);
                        *(u32x2*)(dst + 16 * dt) = w;
                    }
                }
        }
    }
#undef BD_PARAMS
#undef BD_FETCH
    __syncthreads();
}

struct NoFn { __device__ __forceinline__ f32x4 init(int) const { return (f32x4){0.f, 0.f, 0.f, 0.f}; } __device__ __forceinline__ f32x4 apply(f32x4 s, int, int) const { return s; } };

__device__ __forceinline__ void xattn_phase(const Params& p, LAS unsigned char* lds, int layer) {
    int tid_l = threadIdx.x; asm volatile("" : "+v"(tid_l)); const int tid = tid_l, lane = tid & 63, wid = __builtin_amdgcn_readfirstlane(tid >> 6), li = lane & 15, g = lane >> 4;
    const bf16_t* Q = (const bf16_t*)(p.ws + WS_R1);
    const bf16_t* KV = (const bf16_t*)(p.ws + WS_KV + (size_t)layer * 32 * MiB);
    bf16_t* Y = (bf16_t*)(p.ws + WS_Y);
    LAS unsigned char* T = lds;
    const int nunits = NB * 4 * 8;
    const bool xmap = (gridDim.x == 256);
    const int vcu = __builtin_amdgcn_readfirstlane(*(volatile LAS int*)(lds + LDS_BYTES - 48));
    for (int unit = blockIdx.x; unit < nunits; unit += gridDim.x) {
        int bh = unit >> 3, qb = unit & 7;
        if (xmap) { const int x = vcu & 7, v = vcu >> 3, i = unit >> 8; bh = x * 16 + 4 * i + (v >> 3); qb = v & 7; }
        const int b = bh >> 2, h = bh & 3;
        const bf16_t* Qb = Q + ((size_t)b * SEQ + qb * 256 + 32 * wid) * DM + 256 * h;
        bf16_t* Yb = Y + ((size_t)b * SEQ + qb * 256 + 32 * wid) * DM + 256 * h;
        const unsigned qoff = (unsigned)li * DM + 8 * g;
        const bf16_t* kvb = KV + (size_t)b * MEMLEN * 2 * DM + 256 * h;
        u32x4 rr[16];
#define XA_LOAD() do { _Pragma("unroll") for (int i = 0; i < 16; ++i) { rr[i] = *(const u32x4*)gp; gp += 16 * 2 * DM; asm volatile("" : "+v"(gp)); } } while (0)
#define XA_STORE() do { _Pragma("unroll") for (int i = 0; i < 16; ++i) { *(LAS u32x4*)lp = rr[i]; lp += 16 * 544; asm volatile("" : "+v"(lp)); } } while (0)
        const bf16_t* gp = kvb + (unsigned)((tid >> 5) * 2 * DM + 8 * (tid & 31));
        LAS unsigned char* lp = T + (tid >> 5) * 544 + (tid & 31) * 16;
        asm volatile("" : "+v"(gp)); asm volatile("" : "+v"(lp));
        XA_LOAD();
        __syncthreads();
        XA_STORE();
        __syncthreads();
        f32x4 S[2][16];
#pragma unroll
        for (int qt = 0; qt < 2; ++qt)
#pragma unroll
            for (int kt = 0; kt < 16; ++kt) S[qt][kt] = (f32x4){0.f, 0.f, 0.f, 0.f};
        LAS const unsigned char* kbase = T + li * 544 + 16 * g;
#pragma unroll
        for (int kq = 0; kq < 4; ++kq) {
            bf16x8 Qf[2][2];
#pragma unroll
            for (int qt = 0; qt < 2; ++qt)
#pragma unroll
                for (int j = 0; j < 2; ++j) Qf[qt][j] = __builtin_nontemporal_load((const bf16x8*)(Qb + (qoff + (unsigned)(16 * qt * DM + 32 * (2 * kq + j)))));
            LAS const unsigned char* kp = kbase + 128 * kq;
            asm volatile("" : "+v"(kp));
            bf16x8 kf[2][2];
#pragma unroll
            for (int j = 0; j < 2; ++j) kf[0][j] = *(LAS const bf16x8*)(kp + 64 * j);
#pragma unroll
            for (int kt = 0; kt < 16; ++kt) {
                if (kt + 1 < 16) {
                    kp += 16 * 544; asm volatile("" : "+v"(kp));
#pragma unroll
                    for (int j = 0; j < 2; ++j) kf[(kt + 1) & 1][j] = *(LAS const bf16x8*)(kp + 64 * j);
                }
                __builtin_amdgcn_sched_barrier(0); __builtin_amdgcn_s_setprio(1);
#pragma unroll
                for (int j = 0; j < 2; ++j)
#pragma unroll
                    for (int qt = 0; qt < 2; ++qt) S[qt][kt] = __builtin_amdgcn_mfma_f32_16x16x32_bf16(kf[kt & 1][j], Qf[qt][j], S[qt][kt], 0, 0, 0);
__builtin_amdgcn_s_setprio(0); __builtin_amdgcn_sched_barrier(0);
            }
        }
        float linv[2];
        bf16x8 Pf[2][8];
#pragma unroll
        for (int qt = 0; qt < 2; ++qt) {
            float mx = -INFINITY;
#pragma unroll
            for (int kt = 0; kt < 16; ++kt) { mx = max3f(mx, S[qt][kt][0], S[qt][kt][1]); mx = max3f(mx, S[qt][kt][2], S[qt][kt][3]); }
            mx = quad_max(mx);
            float ps = 0.f;
#pragma unroll
            for (int kt = 0; kt < 16; ++kt)
#pragma unroll
                for (int e = 0; e < 4; ++e) { const float pv = ex2(S[qt][kt][e] - mx); S[qt][kt][e] = pv; ps += pv; }
            linv[qt] = 1.0f / quad_sum(ps);
#pragma unroll
            for (int s = 0; s < 8; ++s) {
                u32x4 w; w.x = pk2(S[qt][2 * s][0], S[qt][2 * s][1]); w.y = pk2(S[qt][2 * s][2], S[qt][2 * s][3]);
                w.z = pk2(S[qt][2 * s + 1][0], S[qt][2 * s + 1][1]); w.w = pk2(S[qt][2 * s + 1][2], S[qt][2 * s + 1][3]);
                Pf[qt][s] = __builtin_bit_cast(bf16x8, w);
            }
            __builtin_amdgcn_sched_barrier(0);
        }
        gp = kvb + (unsigned)((tid >> 5) * 2 * DM + 8 * (tid & 31) + DM); lp = T + (tid >> 5) * 544 + (tid & 31) * 16;
        asm volatile("" : "+v"(gp)); asm volatile("" : "+v"(lp));
        XA_LOAD();
        __syncthreads();
        XA_STORE();
        __syncthreads();
#undef XA_LOAD
#undef XA_STORE
        const int q4 = li >> 2, pp = li & 3;
        LAS const unsigned char* vbase = T + (4 * g + q4) * 544 + 8 * pp;
#pragma unroll
        for (int dh = 0; dh < 2; ++dh) {
            f32x4 O[2][8];
#pragma unroll
            for (int qt = 0; qt < 2; ++qt)
#pragma unroll
                for (int dt = 0; dt < 8; ++dt) O[qt][dt] = (f32x4){0.f, 0.f, 0.f, 0.f};
            s16x4 va[2][4][2];
            LAS const unsigned char* vp = vbase + 32 * (8 * dh);
            asm volatile("" : "+v"(vp));
#pragma unroll
            for (int j = 0; j < 4; ++j) { va[0][j][0] = vtr(vp + 32 * j); va[0][j][1] = vtr(vp + 16 * 544 + 32 * j); }
#pragma unroll
            for (int bi = 0; bi < 16; ++bi) {
                if (bi + 1 < 16) {
                    if (((bi + 1) & 1) == 0) { vp += 32 * 544; asm volatile("" : "+v"(vp)); }
                    const int d1 = 4 * ((bi + 1) & 1);
#pragma unroll
                    for (int j = 0; j < 4; ++j) { va[(bi + 1) & 1][j][0] = vtr(vp + 32 * (d1 + j)); va[(bi + 1) & 1][j][1] = vtr(vp + 16 * 544 + 32 * (d1 + j)); }
                }
                __builtin_amdgcn_sched_barrier(0); __builtin_amdgcn_s_setprio(1);
                const int s = bi >> 1, d0 = 4 * (bi & 1);
#pragma unroll
                for (int j = 0; j < 4; ++j) {
                    const s16x4 a1 = va[bi & 1][j][0], a2 = va[bi & 1][j][1];
                    const bf16x8 vf = (bf16x8){a1[0], a1[1], a1[2], a1[3], a2[0], a2[1], a2[2], a2[3]};
#pragma unroll
                    for (int qt = 0; qt < 2; ++qt) O[qt][d0 + j] = __builtin_amdgcn_mfma_f32_16x16x32_bf16(vf, Pf[qt][s], O[qt][d0 + j], 0, 0, 0);
                }
__builtin_amdgcn_s_setprio(0); __builtin_amdgcn_sched_barrier(0);
            }
#pragma unroll
            for (int qt = 0; qt < 2; ++qt) {
                bf16_t* dst = Yb + ((unsigned)li * DM + (unsigned)(16 * qt * DM + 128 * dh) + 4 * g);
#pragma unroll
                for (int dt = 0; dt < 8; ++dt) { const f32x4 o = O[qt][dt] * linv[qt]; u32x2 w; w.x = pk2(o[0], o[1]); w.y = pk2(o[2], o[3]); *(u32x2*)(dst + 16 * dt) = w; }
            }
        }
    }
    __syncthreads();
}

__device__ __forceinline__ void final_phase(const Params& p) {
    int tid_l = threadIdx.x; asm volatile("" : "+v"(tid_l)); const int tid = tid_l, lane = tid & 63, wid = tid >> 6;
    const float* ssq = (const float*)(p.ws + WS_SSQ);
    const bf16_t* hb = (const bf16_t*)(p.ws + WS_HB);
    const int gw = blockIdx.x * 8 + wid, NGW = gridDim.x * 8;
    for (int row = gw; row < MTOK; row += NGW) {
        const float rs = pg8::row_rstd(ssq, row);
#pragma unroll
        for (int i = 0; i < 2; ++i) {
            const int c0 = 8 * (lane + 64 * i);
            const u32x4 bw = *(const u32x4*)(hb + (size_t)row * DM + c0);
            const f32x4 g0 = *(const f32x4*)(p.in[25] + c0), g1 = *(const f32x4*)(p.in[25] + c0 + 4);
            f32x4 o0, o1;
            o0[0] = __uint_as_float(bw.x << 16) * rs * g0[0]; o0[1] = __uint_as_float(bw.x & 0xffff0000u) * rs * g0[1];
            o0[2] = __uint_as_float(bw.y << 16) * rs * g0[2]; o0[3] = __uint_as_float(bw.y & 0xffff0000u) * rs * g0[3];
            o1[0] = __uint_as_float(bw.z << 16) * rs * g1[0]; o1[1] = __uint_as_float(bw.z & 0xffff0000u) * rs * g1[1];
            o1[2] = __uint_as_float(bw.w << 16) * rs * g1[2]; o1[3] = __uint_as_float(bw.w & 0xffff0000u) * rs * g1[3];
            f32x4* dst = (f32x4*)(p.out + (size_t)row * DM + c0);
            __builtin_nontemporal_store(o0, dst); __builtin_nontemporal_store(o1, dst + 1);
        }
    }
}

#define XB_TMO      128
#define XB_XCNT(j)  (256  + 64 * (j))
#define XB_XSUB(j)  (1280 + 64 * (j))
#define XB_XGEN(j)  (2304 + 64 * (j))
#define XB_TOP      3328
#define XB_TOPGEN   3392
#define XCD_BAR_WORDS 3456
#define XB_SPIN_CAP (1u << 18)

__device__ __forceinline__ unsigned xb_ld(unsigned* p)              { return __hip_atomic_load(p, __ATOMIC_RELAXED, __HIP_MEMORY_SCOPE_AGENT); }
__device__ __forceinline__ unsigned xb_add(unsigned* p, unsigned v) { return __hip_atomic_fetch_add(p, v, __ATOMIC_RELAXED, __HIP_MEMORY_SCOPE_AGENT); }
__device__ __forceinline__ unsigned xb_xcc_id() { return (unsigned)__builtin_amdgcn_s_getreg((3 << 11) | 20) & 0xFu; }
#define XB_SPIN(cond, bar) do { unsigned _sp = 0; while (cond) { __builtin_amdgcn_s_sleep(1); \
    if ((++_sp & 255u) == 0u) { if (xb_ld(&(bar)[XB_TMO])) break; if (_sp > XB_SPIN_CAP) { atomicAdd(&(bar)[XB_TMO], 1u); break; } } } } while (0)

struct XcdBarrier {
    unsigned* bar; unsigned x;
    volatile LAS unsigned* st;
};

__device__ __forceinline__ XcdBarrier xcd_barrier_post(unsigned* bar, volatile LAS unsigned* st) {
    XcdBarrier b; b.bar = bar; b.x = xb_xcc_id(); b.st = st;
    if (threadIdx.x == 0) (void)xb_add(&bar[XB_XCNT(b.x)], 1u);
    return b;
}
__device__ __forceinline__ void xcd_barrier_complete(unsigned* bar, unsigned x, unsigned& nloc, unsigned& nx) {
    const unsigned G = gridDim.x * gridDim.y * gridDim.z;
    unsigned sum, cnt, mine, sp = 0u;
    for (;;) {
        sum = 0u; cnt = 0u; mine = 0u;
#pragma unroll
        for (unsigned j = 0; j < 16; ++j) { const unsigned c = xb_ld(&bar[XB_XCNT(j)]); sum += c; cnt += (c > 0u) ? 1u : 0u; mine = (j == x) ? c : mine; }
        if (sum == G) break;
        __builtin_amdgcn_s_sleep(1);
        if ((++sp & 255u) == 0u) { if (xb_ld(&bar[XB_TMO])) break; if (sp > XB_SPIN_CAP) { atomicAdd(&bar[XB_TMO], 1u); break; } }
    }
    nloc = mine > 0u ? mine : 1u; nx = cnt > 0u ? cnt : 1u;
}

__device__ __forceinline__ void xcd_barrier(const XcdBarrier& b) {
    asm volatile("s_waitcnt vmcnt(0)" ::: "memory");
    __syncthreads();
    if (threadIdx.x == 0) {
        unsigned* bar = b.bar;
        __builtin_amdgcn_s_waitcnt(0);
        unsigned nloc = b.st[0], nx = b.st[1];
        if (nloc == 0u) { xcd_barrier_complete(bar, b.x, nloc, nx); b.st[0] = nloc; b.st[1] = nx; }
        const unsigned old = xb_add(&bar[XB_XSUB(b.x)], 1u);
        const unsigned gen = old / nloc;
        if (old + 1u == (gen + 1u) * nloc) {
            __builtin_amdgcn_fence(__ATOMIC_RELEASE, "agent");
            asm volatile("s_waitcnt vmcnt(0)" ::: "memory");
            const unsigned og = xb_add(&bar[XB_TOP], 1u);
            const unsigned tg = og / nx;
            if (og + 1u == (tg + 1u) * nx) xb_add(&bar[XB_TOPGEN], 1u);
            else XB_SPIN(xb_ld(&bar[XB_TOPGEN]) == tg, bar);
            __builtin_amdgcn_fence(__ATOMIC_ACQUIRE, "agent");
            xb_add(&bar[XB_XGEN(b.x)], 1u);
            asm volatile("s_waitcnt vmcnt(0)" ::: "memory");
        } else {
            XB_SPIN(xb_ld(&bar[XB_XGEN(b.x)]) == gen, bar);
            __builtin_amdgcn_fence(__ATOMIC_ACQUIRE, "agent");
            asm volatile("s_waitcnt vmcnt(0)" ::: "memory");
        }
    }
    __syncthreads();
}

template <class Epi>
__device__ __forceinline__ void run_gemm(LAS unsigned char* lds, const bf16_t* A, const bf16_t* Bt, int M, int N, int K, const Epi& E) {
    pg8::Gemm g{A, Bt, M, N, K};
    const int vcu = __builtin_amdgcn_readfirstlane(*(volatile LAS int*)(lds + LDS_BYTES - 48));
    pg8::StaticOrder S; S.init(M, N, (int)gridDim.x, vcu);
    pg8::gemm_phase<Epi, pg8::StaticOrder, true, true>(lds, g, S, E);
    __syncthreads();
}

__global__ void __launch_bounds__(512, 2) mega_fwd(Params p) {
    extern __shared__ __attribute__((aligned(16))) unsigned char lds_raw[];
    LAS unsigned char* lds = (LAS unsigned char*)lds_raw;
    cg::grid_group grid = cg::this_grid();
    volatile LAS unsigned* bst = (volatile LAS unsigned*)(lds + LDS_BYTES - 64);
    if (threadIdx.x < 2) bst[threadIdx.x] = 0u;
    __syncthreads();
    const XcdBarrier xbar = xcd_barrier_post((unsigned*)(p.ws + WS_BAR), bst);
    volatile LAS int* vslot = (volatile LAS int*)(lds + LDS_BYTES - 48);
    unsigned* census = (unsigned*)(p.ws + WS_BAR + 16384);
    if (threadIdx.x == 0) { const unsigned mx_ = hw_xcc_id() & 7u; vslot[1] = (int)mx_; vslot[2] = (int)__hip_atomic_fetch_add(census + 64 * mx_, 1u, __ATOMIC_RELAXED, __HIP_MEMORY_SCOPE_AGENT); }
    unsigned char* ws = p.ws;
    bf16_t* hb = (bf16_t*)(ws + WS_HB);
    float* ssq = (float*)(ws + WS_SSQ);
    bf16_t* R1 = (bf16_t*)(ws + WS_R1);
    bf16_t* Y = (bf16_t*)(ws + WS_Y);

    p0_prologue(p, lds);
#if PROBE_DUP == 4
    p0_prologue(p, lds);
#endif
    grid.sync();
    if (threadIdx.x == 0) {
        unsigned v = 0; const unsigned my_x = (unsigned)vslot[1], my_rank = (unsigned)vslot[2];
#pragma unroll 1
        for (unsigned x = 0; x < 8; ++x) { const unsigned n = __hip_atomic_load(census + 64 * x, __ATOMIC_RELAXED, __HIP_MEMORY_SCOPE_AGENT); v += (n < my_rank ? n : my_rank) + ((x < my_x && n > my_rank) ? 1u : 0u); }
        vslot[0] = (int)v;
    }
    __syncthreads();
    fox_cumsum(p);
    __syncthreads();
    for (int l = 0; l < 2; ++l) {
        pg8::EpiScale<0> E{(bf16_t*)(ws + WS_KV + (size_t)l * 32 * MiB), 2 * DM, nullptr};
        run_gemm(lds, (const bf16_t*)(ws + WS_MEMN + (size_t)l * 16 * MiB), (const bf16_t*)(ws + WS_WKV + (size_t)l * 4 * MiB), MMEM, 2 * DM, DM, E);
    }
    for (int layer = 0; layer < 2; ++layer) {
        if (layer == 0) {
            pg8::EpiScale<0> E{R1, ABN, ssq};
            run_gemm(lds, hb, (const bf16_t*)(ws + WS_WIN0), MTOK, ABN, DM, E);
            xcd_barrier(xbar);
            lru_phase(p, lds);
#if PROBE_DUP == 1
            lru_phase(p, lds);
#endif
            fox_phase(p, lds);
#if PROBE_DUP == 2
            fox_phase(p, lds);
#endif
            xcd_barrier(xbar);
            pg8::EpiResid E2{hb, ssq};
            run_gemm(lds, Y, (const bf16_t*)(ws + WS_WOUT0), MTOK, DM, DM, E2);
        } else {
            pg8::EpiRope E{R1, ssq, (const f32x2*)(ws + WS_ROPE)};
            run_gemm(lds, hb, (const bf16_t*)(ws + WS_WIN1), MTOK, CDN, DM, E);
#if PROBE_DUP == 8
            run_gemm(lds, hb, (const bf16_t*)(ws + WS_WIN1), MTOK, CDN, DM, E);
#endif
            xcd_barrier(xbar);
            d16_phase(p, lds);
            d4_phase(p, lds);
            swa_phase(p, lds);
#if PROBE_DUP == 14
            d16_phase(p, lds);
            d4_phase(p, lds);
            swa_phase(p, lds);
#endif
            xcd_barrier(xbar);
#if PROBE_DUP == 13
            swa_phase(p, lds);
#endif
            band_phase(p, lds);
#if PROBE_DUP == 3
            band_phase(p, lds, 1);
#endif
            xcd_barrier(xbar);
            pg8::EpiResid E2{hb, ssq};
            run_gemm(lds, Y, (const bf16_t*)(ws + WS_WOUT1), MTOK, DM, DM, E2);
        }
        xcd_barrier(xbar);
        {
            pg8::EpiScale<0> E{R1, DM, ssq};
            run_gemm(lds, hb, (const bf16_t*)(ws + WS_WQ + (size_t)layer * 2 * MiB), MTOK, DM, DM, E);
#if PROBE_DUP == 7
            run_gemm(lds, hb, (const bf16_t*)(ws + WS_WQ + (size_t)layer * 2 * MiB), MTOK, DM, DM, E);
#endif
            xcd_barrier(xbar);
            xattn_phase(p, lds, layer);
#if PROBE_DUP == 5
            xattn_phase(p, lds, layer);
#endif
            xcd_barrier(xbar);
            pg8::EpiResid E2{hb, ssq};
            run_gemm(lds, Y, (const bf16_t*)(ws + WS_WO + (size_t)layer * 2 * MiB), MTOK, DM, DM, E2);
        }
        xcd_barrier(xbar);
        {
            pg8::EpiScale<1> E{R1, DFF, ssq};
            run_gemm(lds, hb, (const bf16_t*)(ws + WS_WUP + (size_t)layer * 8 * MiB), MTOK, DFF, DM, E);
#if PROBE_DUP == 6
            run_gemm(lds, hb, (const bf16_t*)(ws + WS_WUP + (size_t)layer * 8 * MiB), MTOK, DFF, DM, E);
#endif
            xcd_barrier(xbar);
            pg8::EpiResid E2{hb, ssq};
#if PROBE_DUP == 9
            { pg8::EpiResid E3{Y, (float*)(ws + WS_CS)}; run_gemm(lds, R1, (const bf16_t*)(ws + WS_WDN + (size_t)layer * 8 * MiB), MTOK, DM, DFF, E3); }
#endif
            run_gemm(lds, R1, (const bf16_t*)(ws + WS_WDN + (size_t)layer * 8 * MiB), MTOK, DM, DFF, E2);
        }
        xcd_barrier(xbar);
    }
#if PROBE_DUP == 10
    for (int i = 0; i < 10; ++i) xcd_barrier(xbar);
#endif
    final_phase(p);
#if PROBE_DUP == 11
    if (threadIdx.x == 0 && (hw_xcc_id() & 7u) != (blockIdx.x & 7u)) p.out[blockIdx.x] = __builtin_nanf("");
#endif
}

extern "C" void kernel_launch(void* const* d_in, const int* in_sizes, int n_in, void* d_out, int out_size, void* d_ws, size_t ws_size, hipStream_t stream) {
    static int grid = 0;
    if (grid == 0) {
        if (n_in != 26 || out_size != MTOK * DM || ws_size < WS_END) { fprintf(stderr, "kernel_launch: unexpected shapes (n_in %d out %d ws %zu)\n", n_in, out_size, ws_size); grid = -1; return; }
        int dev = 0, cus = 0, per_cu = 0;
        hipGetDevice(&dev);
        hipDeviceGetAttribute(&cus, hipDeviceAttributeMultiprocessorCount, dev);
        if (hipFuncSetAttribute((const void*)mega_fwd, hipFuncAttributeMaxDynamicSharedMemorySize, LDS_BYTES) != hipSuccess) { fprintf(stderr, "kernel_launch: hipFuncSetAttribute failed\n"); grid = -1; return; }
        if (hipOccupancyMaxActiveBlocksPerMultiprocessor(&per_cu, (const void*)mega_fwd, 512, LDS_BYTES) != hipSuccess || per_cu < 1) { fprintf(stderr, "kernel_launch: occupancy query says %d\n", per_cu); per_cu = 1; }
        (void)hipGetLastError();
        grid = cus * per_cu;
    }
    if (grid < 0) return;
    if (hipMemsetAsync((char*)d_ws + WS_BAR, 0, WS_BAR_BYTES, stream) != hipSuccess) { fprintf(stderr, "kernel_launch: memset failed\n"); return; }
    Params prm{};
    for (int i = 0; i < 26; ++i) prm.in[i] = (const float*)d_in[i];
    prm.out = (float*)d_out; prm.ws = (unsigned char*)d_ws;
    void* args[] = {&prm};
    hipError_t e = hipLaunchCooperativeKernel((const void*)mega_fwd, dim3(grid), dim3(512), args, LDS_BYTES, stream);
    if (e != hipSuccess) fprintf(stderr, "cooperative launch failed: %s (grid %d)\n", hipGetErrorString(e), grid);
}
```
